# Optimizing an MI355X kernel written in HIP

```python
import jax, jax.numpy as jnp
from jax import lax
import numpy as np

D_MODEL = 1024
BATCH = 2
SEQ = 8192
DEPTH = 2
DEC_BATCH = 128
DEC_SEQ = 4
PAST_LEN = 8192
PAGE_SIZE = 128

N_BRANCH = 4
BRANCH_W = D_MODEL // 4
SC_WIDTH = 3
GM_CHUNK = 128
GM_GROUPS = 4
GM_GROUP_W = BRANCH_W // GM_GROUPS
MLA_HEADS = 4
QK_NOPE = BRANCH_W // MLA_HEADS
QK_ROPE = QK_NOPE // 2
V_HEAD = BRANCH_W // MLA_HEADS
Q_RANK = D_MODEL // 4
KV_RANK = D_MODEL // 8
ROPE_THETA = 10000.0
ATTN_BLOCK = 128
CF_WIDTH = 31
D_FF = ((8 * D_MODEL // 3 + 255) // 256) * 256
RMS_EPS = 1e-6
LN_EPS = 1e-5

IN_SIZES = (BRANCH_W, BRANCH_W, BRANCH_W,
            BRANCH_W, BRANCH_W,
            Q_RANK, KV_RANK, QK_ROPE,
            BRANCH_W, BRANCH_W,
            N_BRANCH * D_MODEL)
IN_COLS = sum(IN_SIZES)

kernel_name = 'hybrid_parallel_gated_mla_conv_gmlp_decode_step'


def rms_norm(x, g):
    xf = x.astype(jnp.float32)
    y = xf * lax.rsqrt(jnp.mean(xf * xf, axis=-1, keepdims=True) + RMS_EPS)
    return (y * g.astype(jnp.float32)).astype(x.dtype)


def layer_norm(x, g, b):
    xf = x.astype(jnp.float32)
    mu = jnp.mean(xf, axis=-1, keepdims=True)
    var = jnp.mean(jnp.square(xf - mu), axis=-1, keepdims=True)
    y = (xf - mu) * lax.rsqrt(var + LN_EPS)
    return (y * g.astype(jnp.float32) + b.astype(jnp.float32)).astype(x.dtype)


def swiglu(x, wg, wu, wd):
    return (jax.nn.silu(x @ wg) * (x @ wu)) @ wd


def rope(x, pos):
    half = x.shape[-1] // 2
    inv = ROPE_THETA ** (-jnp.arange(half, dtype=jnp.float32) / half)
    ang = pos.astype(jnp.float32)[:, None] * inv[None, :]
    shape = (1, pos.shape[0]) + (1,) * (x.ndim - 3) + (half,)
    cos = jnp.cos(ang).reshape(shape)
    sin = jnp.sin(ang).reshape(shape)
    x1 = x[..., :half].astype(jnp.float32)
    x2 = x[..., half:].astype(jnp.float32)
    return jnp.concatenate([x1 * cos - x2 * sin, x2 * cos + x1 * sin], axis=-1).astype(x.dtype)


def causal_dwconv(u, buf, w):
    k = w.shape[0]
    full = jnp.concatenate([buf.astype(u.dtype), u], axis=1)
    out = lax.conv_general_dilated(full, w[:, None, :].astype(u.dtype), window_strides=(1,),
                                   padding='VALID', dimension_numbers=('NWC', 'WIO', 'NWC'),
                                   feature_group_count=u.shape[-1])
    return out, full[:, full.shape[1] - (k - 1):]


def spatial_gate_mix(v, ws, bs):
    n, t, _ = v.shape
    c = min(t, GM_CHUNK)
    wm = (ws * jnp.tril(jnp.ones((GM_CHUNK, GM_CHUNK), ws.dtype)))[:, :c, :c]
    vc = v.reshape(n, t // c, c, GM_GROUPS, GM_GROUP_W)
    out = jnp.einsum('gij,nkjgw->nkigw', wm, vc) + bs[:, :c].T[None, None, :, :, None]
    return out.reshape(n, t, BRANCH_W)


def causal_block_attention(q, k, v, scale):
    n, t, h, e = q.shape
    nb = t // ATTN_BLOCK
    qb = q.reshape(n, nb, ATTN_BLOCK, h, e).transpose(1, 0, 2, 3, 4)
    kpos = jnp.arange(t)

    def block(args):
        qi, bi = args
        qpos = bi * ATTN_BLOCK + jnp.arange(ATTN_BLOCK)
        s = jnp.einsum('nqhe,nkhe->nhqk', qi, k).astype(jnp.float32) * scale
        s = jnp.where(kpos[None, :] <= qpos[:, None], s, -jnp.inf)
        p = jax.nn.softmax(s, axis=-1).astype(v.dtype)
        return jnp.einsum('nhqk,nkhd->nqhd', p, v)

    o = lax.map(block, (qb, jnp.arange(nb)))
    return o.transpose(1, 0, 2, 3, 4).reshape(n, t, h, v.shape[-1])


def latent_decode_attention(q_nope, q_pe, lat, kr, past_lat, past_kr, w_uk, w_uv, scale):
    t = q_nope.shape[1]
    p_len = past_lat.shape[1]
    q_lat = jnp.einsum('nthd,chd->nthc', q_nope, w_uk)
    s_past = (jnp.einsum('nthc,npc->nhtp', q_lat, past_lat)
              + jnp.einsum('nthr,npr->nhtp', q_pe, past_kr)).astype(jnp.float32) * scale
    s_new = (jnp.einsum('nthc,nsc->nhts', q_lat, lat)
             + jnp.einsum('nthr,nsr->nhts', q_pe, kr)).astype(jnp.float32) * scale
    s_new = jnp.where(jnp.tril(jnp.ones((t, t), bool))[None, None], s_new, -jnp.inf)
    prob = jax.nn.softmax(jnp.concatenate([s_past, s_new], axis=-1), axis=-1).astype(lat.dtype)
    o_lat = (jnp.einsum('nhtp,npc->nthc', prob[..., :p_len], past_lat)
             + jnp.einsum('nhts,nsc->nthc', prob[..., p_len:], lat))
    return jnp.einsum('nthc,chd->nthd', o_lat, w_uv)


def mla(c_q, c_kv, c_kr, pos, past_lat, past_kr, lp):
    n, t, _ = c_q.shape
    q = jnp.einsum('ntr,rhe->nthe', rms_norm(c_q, lp['q_norm']), lp['w_uq'])
    q_nope = q[..., :QK_NOPE]
    q_pe = rope(q[..., QK_NOPE:], pos)
    lat = rms_norm(c_kv, lp['kv_norm'])
    kr = rope(c_kr, pos)
    scale = (QK_NOPE + QK_ROPE) ** -0.5
    if past_lat is None:
        k_nope = jnp.einsum('ntc,chd->nthd', lat, lp['w_uk'])
        vv = jnp.einsum('ntc,chd->nthd', lat, lp['w_uv'])
        k = jnp.concatenate([k_nope, jnp.broadcast_to(kr[:, :, None, :], (n, t, MLA_HEADS, QK_ROPE))], axis=-1)
        o = causal_block_attention(jnp.concatenate([q_nope, q_pe], axis=-1), k, vv, scale)
    else:
        o = latent_decode_attention(q_nope, q_pe, lat, kr, past_lat, past_kr, lp['w_uk'], lp['w_uv'], scale)
    return o.reshape(n, t, MLA_HEADS * V_HEAD), lat, kr


def split_points():
    pts, acc = [], 0
    for s in IN_SIZES[:-1]:
        acc += s
        pts.append(acc)
    return pts


def token_mixer(xn, pos, buf_a, buf_d, past_lat, past_kr, lp):
    n, t, _ = xn.shape
    z = xn @ lp['w_in']
    (a_h, a_c, a_b, b_u, b_v, c_q, c_kv, c_kr, d_val, d_gate, gate_logits) = jnp.split(z, split_points(), axis=-1)
    a_conv, new_buf_a = causal_dwconv(a_c * a_h, buf_a, lp['sc_w'])
    y_a = a_b * a_conv
    u = jax.nn.gelu(b_u)
    v = rms_norm(jax.nn.gelu(b_v), lp['gm_norm'])
    y_b = u * spatial_gate_mix(v, lp['gm_ws'], lp['gm_bs'])
    y_c, lat, kr = mla(c_q, c_kv, c_kr, pos, past_lat, past_kr, lp)
    d_conv, new_buf_d = causal_dwconv(d_val * jax.nn.sigmoid(d_gate), buf_d, lp['cf_w'])
    y_d = jax.nn.silu(layer_norm(d_conv + lp['cf_b'], lp['cf_ln_g'], lp['cf_ln_b']))
    ys = jnp.stack([y_a, y_b, y_c, y_d], axis=2)
    branch = jnp.einsum('ntiw,iwd->ntid', ys, lp['w_branch'])
    gates = jax.nn.sigmoid(gate_logits.reshape(n, t, N_BRANCH, D_MODEL))
    merged = jnp.sum(gates * branch, axis=2)
    return merged @ lp['w_out'], new_buf_a, new_buf_d, lat, kr, v


def decoder_layer(h, pos, buf_a, buf_d, past_lat, past_kr, lp):
    h = h + 0.5 * swiglu(rms_norm(h, lp['n1']), lp['f1_g'], lp['f1_u'], lp['f1_d'])
    m, nba, nbd, lat, kr, v = token_mixer(rms_norm(h, lp['nm']), pos, buf_a, buf_d, past_lat, past_kr, lp)
    h = h + m
    h = h + 0.5 * swiglu(rms_norm(h, lp['n2']), lp['f2_g'], lp['f2_u'], lp['f2_d'])
    return h, nba, nbd, lat, kr, v


def setup_inputs(seed: int = 0) -> dict:
    key = jax.random.key(seed)
    ks = iter(jax.random.split(key, 48))
    f32 = jnp.float32

    def nrm(shape, scale):
        return jax.random.normal(next(ks), shape, f32) * scale

    def gain(shape):
        return 1.0 + 0.02 * jax.random.normal(next(ks), shape, f32)

    n_pages = PAST_LEN // PAGE_SIZE
    n_used = DEC_BATCH * n_pages
    n_pool = n_used + max(1, n_used // 4)
    perm = jax.random.permutation(next(ks), n_pool)
    page_table = perm[:n_used].reshape(DEC_BATCH, n_pages).astype(jnp.int32)
    return {
        'x_prompt': nrm((BATCH, SEQ, D_MODEL), 1.0),
        'x_sample': nrm((DEC_BATCH, DEC_SEQ, D_MODEL), 1.0),
        'cache_mla_latent': nrm((DEPTH, n_pool, PAGE_SIZE, KV_RANK), 1.0),
        'cache_mla_krope': nrm((DEPTH, n_pool, PAGE_SIZE, QK_ROPE), 1.0),
        'page_table': page_table,
        'state_conv_a': nrm((DEPTH, DEC_BATCH, SC_WIDTH - 1, BRANCH_W), 1.0),
        'state_conv_d': nrm((DEPTH, DEC_BATCH, CF_WIDTH - 1, BRANCH_W), 0.5),
        'ffn1_norm': gain((DEPTH, D_MODEL)),
        'ffn1_w_gate': nrm((DEPTH, D_MODEL, D_FF), D_MODEL ** -0.5),
        'ffn1_w_up': nrm((DEPTH, D_MODEL, D_FF), D_MODEL ** -0.5),
        'ffn1_w_down': nrm((DEPTH, D_FF, D_MODEL), D_FF ** -0.5),
        'mix_norm': gain((DEPTH, D_MODEL)),
        'w_in': nrm((DEPTH, D_MODEL, IN_COLS), D_MODEL ** -0.5),
        'sc_conv_w': nrm((DEPTH, SC_WIDTH, BRANCH_W), SC_WIDTH ** -0.5),
        'gm_norm': gain((DEPTH, BRANCH_W)),
        'gm_spatial_w': nrm((DEPTH, GM_GROUPS, GM_CHUNK, GM_CHUNK), GM_CHUNK ** -0.5),
        'gm_spatial_b': nrm((DEPTH, GM_GROUPS, GM_CHUNK), 0.02),
        'mla_q_norm': gain((DEPTH, Q_RANK)),
        'mla_kv_norm': gain((DEPTH, KV_RANK)),
        'mla_w_uq': nrm((DEPTH, Q_RANK, MLA_HEADS, QK_NOPE + QK_ROPE), Q_RANK ** -0.5),
        'mla_w_uk': nrm((DEPTH, KV_RANK, MLA_HEADS, QK_NOPE), KV_RANK ** -0.5),
        'mla_w_uv': nrm((DEPTH, KV_RANK, MLA_HEADS, V_HEAD), KV_RANK ** -0.5),
        'cf_dw_w': nrm((DEPTH, CF_WIDTH, BRANCH_W), CF_WIDTH ** -0.5),
        'cf_dw_b': nrm((DEPTH, BRANCH_W), 0.02),
        'cf_ln_g': gain((DEPTH, BRANCH_W)),
        'cf_ln_b': nrm((DEPTH, BRANCH_W), 0.02),
        'w_branch': nrm((DEPTH, N_BRANCH, BRANCH_W, D_MODEL), BRANCH_W ** -0.5),
        'w_out': nrm((DEPTH, D_MODEL, D_MODEL), D_MODEL ** -0.5),
        'ffn2_norm': gain((DEPTH, D_MODEL)),
        'ffn2_w_gate': nrm((DEPTH, D_MODEL, D_FF), D_MODEL ** -0.5),
        'ffn2_w_up': nrm((DEPTH, D_MODEL, D_FF), D_MODEL ** -0.5),
        'ffn2_w_down': nrm((DEPTH, D_FF, D_MODEL), D_FF ** -0.5),
        'final_norm': gain((D_MODEL,)),
    }


def reference(x_prompt, x_sample, cache_mla_latent, cache_mla_krope, page_table, state_conv_a, state_conv_d,
              ffn1_norm, ffn1_w_gate, ffn1_w_up, ffn1_w_down, mix_norm, w_in, sc_conv_w, gm_norm,
              gm_spatial_w, gm_spatial_b, mla_q_norm, mla_kv_norm, mla_w_uq, mla_w_uk, mla_w_uv,
              cf_dw_w, cf_dw_b, cf_ln_g, cf_ln_b, w_branch, w_out, ffn2_norm, ffn2_w_gate, ffn2_w_up,
              ffn2_w_down, final_norm):
    n_p, t_p, _ = x_prompt.shape
    n_s, t_s, _ = x_sample.shape
    past = page_table.shape[1] * PAGE_SIZE
    pos_p = jnp.arange(t_p, dtype=jnp.int32)
    pos_s = past + jnp.arange(t_s, dtype=jnp.int32)
    zero_a = jnp.zeros((n_p, SC_WIDTH - 1, BRANCH_W), x_prompt.dtype)
    zero_d = jnp.zeros((n_p, CF_WIDTH - 1, BRANCH_W), x_prompt.dtype)

    h_p, h_s = x_prompt, x_sample
    lat_p_l, kr_p_l, ca_p_l, cd_p_l = [], [], [], []
    lat_s_l, kr_s_l, ca_s_l, cd_s_l, v_s_l = [], [], [], [], []
    for l in range(DEPTH):
        lp = dict(n1=ffn1_norm[l], f1_g=ffn1_w_gate[l], f1_u=ffn1_w_up[l], f1_d=ffn1_w_down[l],
                  nm=mix_norm[l], w_in=w_in[l], sc_w=sc_conv_w[l], gm_norm=gm_norm[l],
                  gm_ws=gm_spatial_w[l], gm_bs=gm_spatial_b[l], q_norm=mla_q_norm[l],
                  kv_norm=mla_kv_norm[l], w_uq=mla_w_uq[l], w_uk=mla_w_uk[l], w_uv=mla_w_uv[l],
                  cf_w=cf_dw_w[l], cf_b=cf_dw_b[l], cf_ln_g=cf_ln_g[l], cf_ln_b=cf_ln_b[l],
                  w_branch=w_branch[l], w_out=w_out[l], n2=ffn2_norm[l], f2_g=ffn2_w_gate[l],
                  f2_u=ffn2_w_up[l], f2_d=ffn2_w_down[l])
        h_p, ca_p, cd_p, lat_p, kr_p, _ = decoder_layer(h_p, pos_p, zero_a, zero_d, None, None, lp)
        past_lat = cache_mla_latent[l][page_table].reshape(n_s, past, KV_RANK)
        past_kr = cache_mla_krope[l][page_table].reshape(n_s, past, QK_ROPE)
        h_s, ca_s, cd_s, lat_s, kr_s, v_s = decoder_layer(h_s, pos_s, state_conv_a[l], state_conv_d[l],
                                                          past_lat, past_kr, lp)
        lat_p_l.append(lat_p); kr_p_l.append(kr_p); ca_p_l.append(ca_p); cd_p_l.append(cd_p)
        lat_s_l.append(lat_s); kr_s_l.append(kr_s); ca_s_l.append(ca_s); cd_s_l.append(cd_s)
        v_s_l.append(v_s)

    y_prompt = rms_norm(h_p, final_norm)
    y_sample = rms_norm(h_s, final_norm)
    return (y_prompt, y_sample,
            jnp.stack(lat_p_l), jnp.stack(kr_p_l), jnp.stack(ca_p_l), jnp.stack(cd_p_l),
            jnp.stack(lat_s_l), jnp.stack(kr_s_l), jnp.stack(ca_s_l), jnp.stack(cd_s_l),
            jnp.stack(v_s_l))
```

```cpp
#include <hip/hip_runtime.h>
#include <hip/hip_bf16.h>
#include <cstdio>
#include <cstdint>

#ifndef MK_ONE_LAUNCH
#define MK_ONE_LAUNCH 1
#endif

constexpr int DM = 1024, NPR = 16384, NSR = 512, MROWS = 16896, SEQ = 8192, DFF = 2816, INC = 6304, INP = 6400, BRW = 256;
constexpr int NSEQ_S = 128, TS = 4, NPAGES = 64, PAGE = 128, NPOOL = 10240, KVR = 128, QKR = 32, QKN = 64, QKD = 96, VHD = 64, NHEAD = 4;
constexpr int ZC_AH = 0, ZC_AC = 256, ZC_AB = 512, ZC_BU = 768, ZC_BV = 1024, ZC_CQ = 1280, ZC_CKV = 1536, ZC_CKR = 1664, ZC_DV = 1696, ZC_DG = 1952, ZC_GATE = 2208;
constexpr float RMS_EPS = 1e-6f, LN_EPS = 1e-5f;
constexpr float ATT_C2 = 0.10206207261596575f * 1.4426950408889634f;
__host__ __device__ __forceinline__ size_t kt_off(int row, int h, int d) { const int b = row >> 13, tl = row & (SEQ - 1); return ((size_t)(b * 4 + h) * SEQ + (size_t)(tl & ~63)) * 96 + (size_t)(d >> 3) * 512 + (tl & 63) * 8 + (d & 7); }
__host__ __device__ __forceinline__ size_t vt_off(int row, int h, int d) { const int b = row >> 13, tl = row & (SEQ - 1); return ((size_t)(b * 4 + h) * SEQ + (size_t)(tl & ~63)) * 64 + (size_t)((d >> 5) * 4 + ((tl & 63) >> 4)) * 512 + (tl & 15) * 32 + (d & 31); }
constexpr size_t OFF_YP = 0, OFF_YS = 16777216, OFF_LATP = 17301504, OFF_KRP = 21495808, OFF_CAP = 22544384, OFF_CDP = 22546432,
                 OFF_LATS = 22577152, OFF_KRS = 22708224, OFF_CAS = 22740992, OFF_CDS = 22872064, OFF_VS = 24838144, OUT_TOTAL = 25100288;

constexpr size_t MiB = 1u << 20;
constexpr size_t WS_CTL = 0, CTL_ZERO_BYTES = 4 * MiB;
constexpr size_t WS_WCAT = 2 * MiB, WCAT_BYTES = 1024 * 384 * 2;
constexpr size_t WS_ROPE = 4 * MiB, WS_WSB = 6 * MiB;
constexpr size_t WS_WL = 8 * MiB, WL_STRIDE = 64 * MiB;
constexpr size_t WL_GU1 = 0, WL_D1 = 12 * MiB, WL_IN = 18 * MiB, WL_BR = 31 * MiB, WL_O = 33 * MiB, WL_GU2 = 35 * MiB, WL_D2 = 47 * MiB;
constexpr size_t WS_HB = 144 * MiB, WS_T = 178 * MiB, WS_Z = 272 * MiB, WS_QL = 480 * MiB, WS_QB = 496 * MiB, WS_KB = 512 * MiB, WS_VB = 528 * MiB,
                 WS_YS = 544 * MiB, WS_MG = 580 * MiB, WS_PART = 616 * MiB, WS_SSQ = 684 * MiB  , WS_DUMH = 704 * MiB, WS_DUMS = 740 * MiB  , WS_END = 760 * MiB;
constexpr size_t SSQ_STRIDE = (size_t)MROWS * 16;
constexpr int CW_TMO = 0, CW_CODE = 1, CW_BAR = 4096, CW_Q = 8192, CW_CONVQ = 12288;

constexpr int RING_OFF = 0, RING_BYTES = 131072;
constexpr int LDSCTL_OFF = RING_BYTES, MISC_OFF = LDSCTL_OFF + 320, INTAB_OFF = LDSCTL_OFF + 1024;
constexpr int LDS_BYTES = 163840;
constexpr int QTILE_OFF = LDSCTL_OFF + 2048, QT_STRIDE = 208;
constexpr int NWAVES = 8;

#define GAS __attribute__((address_space(1)))
#define LAS __attribute__((address_space(3)))

template <int CTRL> __device__ __forceinline__ float xl_dpp(float v) { return __builtin_bit_cast(float, __builtin_amdgcn_update_dpp(0, __builtin_bit_cast(int, v), CTRL, 0xf, 0xf, true)); }
__device__ __forceinline__ float xadd1(float v) { return v + xl_dpp<0xB1>(v); }
__device__ __forceinline__ float xadd2(float v) { return v + xl_dpp<0x4E>(v); }
__device__ __forceinline__ float xadd4(float v) { return v + xl_dpp<0x141>(v); }
__device__ __forceinline__ float xadd8(float v) { return v + xl_dpp<0x140>(v); }
__device__ __forceinline__ void xswap16(float& a, float& b) { asm volatile("s_nop 1\n\tv_permlane16_swap_b32 %0, %1\n\ts_nop 1" : "+v"(a), "+v"(b)); }
__device__ __forceinline__ void xswap32(float& a, float& b) { asm volatile("s_nop 1\n\tv_permlane32_swap_b32 %0, %1\n\ts_nop 1" : "+v"(a), "+v"(b)); }
__device__ __forceinline__ float xadd16(float v) { float a = v, b = v; xswap16(a, b); return a + b; }
__device__ __forceinline__ float xadd32(float v) { float a = v, b = v; xswap32(a, b); return a + b; }
__device__ __forceinline__ float xmax16(float v) { float a = v, b = v; xswap16(a, b); return __builtin_fmaxf(a, b); }
__device__ __forceinline__ float xmax32(float v) { float a = v, b = v; xswap32(a, b); return __builtin_fmaxf(a, b); }

namespace pg8 {
#define PG8_LAS __attribute__((address_space(3)))
typedef unsigned short bf16_t;
typedef short bf16x8 __attribute__((ext_vector_type(8)));
typedef float f32x4 __attribute__((ext_vector_type(4)));
typedef float f32x2 __attribute__((ext_vector_type(2)));
typedef unsigned u32x4 __attribute__((ext_vector_type(4)));
typedef unsigned u32x2 __attribute__((ext_vector_type(2)));
constexpr int BM = 256, BK = 64, HALF = 128, HTB = HALF * BK * 2  , STAGE_BYTES = 8 * HTB, NXCD = 8, WGM = 8;

__host__ __device__ __forceinline__ int lds_byte(int r, int c) { const int st = (r >> 4) * 2 + (c >> 5), rr = r & 15, cc = c & 31, ob = rr * 64 + cc * 2; return st * 1024 + (ob ^ (((ob >> 9) & 1) << 5)); }
__host__ __device__ __forceinline__ void stage_rc(int b, int& R, int& C) { const int st = b / 1024, sb = b % 1024, swz = sb ^ (((sb >> 9) & 1) << 5); R = (st >> 1) * 16 + swz / 64; C = (st & 1) * 32 + (swz % 64) / 2; }
__host__ __device__ __forceinline__ int perm32(int rho) { const int n = rho >> 4, i = rho & 15; return 8 * (i >> 2) + 4 * n + (i & 3); }

struct Unit { int pm, pn, sub; };
struct Gemm { int lda, ldb, K; };

template <int NSUB> struct OrderAB {
    int nM, nN, nwg, G, c;
    const char* A; const char* B; size_t a_tile, b_tile, a_sub, b_sub;
    __device__ void init(int M, int N, int G_, int c_) { nM = M / BM; nN = N / BM; nwg = nM * nN; G = G_; c = c_; }
    __device__ bool next(int i, Unit& u) const {
        const int ib = i / NSUB; u.sub = i - ib * NSUB;
        const long L = (long)ib * G + c; if (L >= nwg) return false;
        int wgid = (int)L; { const int q = nwg / NXCD, r = nwg % NXCD, xcd = wgid % NXCD, off = wgid / NXCD; wgid = (xcd < r ? xcd * (q + 1) : r * (q + 1) + (xcd - r) * q) + off; }
        const int nig = WGM * nN, gid = wgid / nig, fm = gid * WGM, gsz = (nM - fm) < WGM ? (nM - fm) : WGM;
        u.pm = fm + ((wgid % nig) % gsz); u.pn = (wgid % nig) / gsz; return true;
    }
    __device__ __forceinline__ const char* a_ptr(const Unit& u) const { return A + (size_t)u.pm * a_tile + (size_t)u.sub * a_sub; }
    __device__ __forceinline__ const char* b_ptr(const Unit& u) const { return B + (size_t)u.pn * b_tile + (size_t)u.sub * b_sub; }
    __device__ __forceinline__ void a_ready(const Unit&) const {}
    __device__ __forceinline__ void done(const Unit&) const {}
};

__device__ __forceinline__ unsigned cvt_pk_bf16(float lo, float hi) { unsigned r; asm volatile("v_cvt_pk_bf16_f32 %0, %1, %2" : "=v"(r) : "v"(lo), "v"(hi)); return r; }
__device__ __forceinline__ float bf_lo(unsigned w) { return __uint_as_float(w << 16); }
__device__ __forceinline__ float bf_hi(unsigned w) { return __uint_as_float(w & 0xffff0000u); }
__device__ __forceinline__ float silu_f(float x) { return x * __builtin_amdgcn_rcpf(1.f + __builtin_amdgcn_exp2f(-1.4426950408889634f * x)); }
__device__ __forceinline__ float sigmoid_f(float x) { return __builtin_amdgcn_rcpf(1.f + __builtin_amdgcn_exp2f(-1.4426950408889634f * x)); }

__device__ __forceinline__ float row_rstd(const float* ssq, int row, int fq) {
    const f32x4 q = *(const f32x4*)(ssq + (size_t)row * 16 + 4 * fq); float s = (q[0] + q[1]) + (q[2] + q[3]); s = xadd32(xadd16(s));
    return __builtin_amdgcn_rsqf(s * (1.0f / DM) + RMS_EPS); }
__device__ __forceinline__ void row_rstd8(const float* ssq, int row0, int fq, float (&rs)[8]) {
#pragma unroll
    for (int k = 0; k < 8; ++k) { const f32x4 q = *(const f32x4*)(ssq + (size_t)(row0 + (k >> 2) * HALF + (k & 3) * 16) * 16 + 4 * fq); rs[k] = (q[0] + q[1]) + (q[2] + q[3]); }
#pragma unroll
    for (int k = 0; k < 8; ++k) rs[k] = xadd32(xadd16(rs[k]));
#pragma unroll
    for (int k = 0; k < 8; ++k) rs[k] = __builtin_amdgcn_rsqf(rs[k] * (1.0f / DM) + RMS_EPS);
}
#define PG8_PRE_FUNCS \
    __device__ __forceinline__ void pre_load(const Unit& u, int wr, int wc, int fr, int fq, f32x4 (&pq)[2]) const { const int row0 = u.pm * BM + wr * 64 + fr; \
        _Pragma("unroll") for (int k2 = 0; k2 < 2; ++k2) { const int k = 2 * wc + k2; pq[k2] = *(const f32x4*)(ssq + (size_t)(row0 + (k >> 2) * HALF + (k & 3) * 16) * 16 + 4 * fq); } } \
    __device__ __forceinline__ void pre_commit(const f32x4 (&pq)[2], int wr, int wc, int fr, int fq, int par) const { float rs[2]; \
        _Pragma("unroll") for (int k = 0; k < 2; ++k) rs[k] = (pq[k][0] + pq[k][1]) + (pq[k][2] + pq[k][3]); \
        _Pragma("unroll") for (int k = 0; k < 2; ++k) rs[k] = xadd32(xadd16(rs[k])); \
        _Pragma("unroll") for (int k = 0; k < 2; ++k) rs[k] = __builtin_amdgcn_rsqf(rs[k] * (1.0f / DM) + RMS_EPS); \
        if (fq == 0) *(PG8_LAS f32x2*)(pre + par * 256 + (wr * 16 + fr) * 8 + 2 * wc) = (f32x2){rs[0], rs[1]}; } \
    __device__ __forceinline__ void pre_get(int wr, int fr, int par, float (&rs)[8]) const { PG8_LAS const float* p = pre + par * 256 + (wr * 16 + fr) * 8; \
        const f32x4 a = *(PG8_LAS const f32x4*)p, b = *(PG8_LAS const f32x4*)(p + 4); rs[0] = a[0]; rs[1] = a[1]; rs[2] = a[2]; rs[3] = a[3]; rs[4] = b[0]; rs[5] = b[1]; rs[6] = b[2]; rs[7] = b[3]; }

struct EpiSwiGLU {
    static constexpr bool PERM = true, AFTER_DRAIN = false, KEEP_ACC = false, HAS_INIT = false, HAS_PRE = true; __device__ __forceinline__ bool keep(const Unit&) const { return false; }
    bf16_t* T; const float* ssq; int ex = 0; PG8_LAS float* pre = nullptr;
    PG8_PRE_FUNCS
    __device__ __forceinline__ void operator()(const f32x4 (&acc)[2][2][4][2], const Unit& u, int wr, int wc, int fr, int fq, int par) const {
        asm volatile("" : "+v"(fr), "+v"(fq));
        const int row0 = u.pm * BM + wr * 64 + fr, col0 = u.pn * 128 + wc * 32 + 8 * fq; float rs8[8]; pre_get(wr, fr, par, rs8);
#pragma unroll
        for (int ai = 0; ai < 2; ++ai)
#pragma unroll
            for (int m = 0; m < 4; ++m) { const int row = row0 + ai * HALF + m * 16; const float rs = rs8[ai * 4 + m];
                f32x4 g0 = acc[ai][0][m][0] * rs, g1 = acc[ai][0][m][1] * rs, u0 = acc[ai][1][m][0] * rs, u1 = acc[ai][1][m][1] * rs;
                u32x4 w;
                if (ex) { w.x = cvt_pk_bf16(g0[0] * u0[0], g0[1] * u0[1]); w.y = cvt_pk_bf16(g0[2] * u0[2], g0[3] * u0[3]); w.z = cvt_pk_bf16(g1[0] * u1[0], g1[1] * u1[1]); w.w = cvt_pk_bf16(g1[2] * u1[2], g1[3] * u1[3]); } else {
                w.x = cvt_pk_bf16(silu_f(g0[0]) * u0[0], silu_f(g0[1]) * u0[1]); w.y = cvt_pk_bf16(silu_f(g0[2]) * u0[2], silu_f(g0[3]) * u0[3]);
                w.z = cvt_pk_bf16(silu_f(g1[0]) * u1[0], silu_f(g1[1]) * u1[1]); w.w = cvt_pk_bf16(silu_f(g1[2]) * u1[2], silu_f(g1[3]) * u1[3]); }
                __builtin_nontemporal_store(w, (u32x4*)(T + (size_t)row * DFF + col0)); }
    }
};
struct EpiZ {
    static constexpr bool PERM = true, AFTER_DRAIN = false, KEEP_ACC = false, HAS_INIT = false, HAS_PRE = true; __device__ __forceinline__ bool keep(const Unit&) const { return false; }
    bf16_t* Z; const float* ssq; PG8_LAS float* pre = nullptr;
    PG8_PRE_FUNCS
    __device__ __forceinline__ void operator()(const f32x4 (&acc)[2][2][4][2], const Unit& u, int wr, int wc, int fr, int fq, int par) const {
        asm volatile("" : "+v"(fr), "+v"(fq));
        const int row0 = u.pm * BM + wr * 64 + fr, col0 = u.pn * BM + wc * 32 + 8 * fq; const bool any_gate = (u.pn * BM + BM) > ZC_GATE; float rs8[8]; pre_get(wr, fr, par, rs8);
#pragma unroll
        for (int ai = 0; ai < 2; ++ai)
#pragma unroll
            for (int m = 0; m < 4; ++m) { const int row = row0 + ai * HALF + m * 16; const float rs = rs8[ai * 4 + m];
                bf16_t* rowp = Z + (size_t)row * INP + col0;
#pragma unroll
                for (int bj = 0; bj < 2; ++bj) { f32x4 v0 = acc[ai][bj][m][0] * rs, v1 = acc[ai][bj][m][1] * rs;
                    if (any_gate) { if (col0 + bj * HALF >= ZC_GATE) {
#pragma unroll
                        for (int e = 0; e < 4; ++e) { v0[e] = __builtin_fmaxf(sigmoid_f(v0[e]), 1e-20f); v1[e] = __builtin_fmaxf(sigmoid_f(v1[e]), 1e-20f); } } }
                    u32x4 w; w.x = cvt_pk_bf16(v0[0], v0[1]); w.y = cvt_pk_bf16(v0[2], v0[3]); w.z = cvt_pk_bf16(v1[0], v1[1]); w.w = cvt_pk_bf16(v1[2], v1[3]);
                    __builtin_nontemporal_store(w, (u32x4*)(rowp + bj * HALF)); } }
    }
};
struct EpiRes {
    static constexpr bool PERM = true, AFTER_DRAIN = false, KEEP_ACC = false, HAS_INIT = true, HAS_PRE = false; __device__ __forceinline__ bool keep(const Unit&) const { return false; }
    bf16_t* hb; float* ssq_out; float scale;
    __device__ __forceinline__ void init(f32x4 (&acc)[2][2][4][2], const Unit& u, int wr, int wc, int fr, int fq) const {
        const int row0 = u.pm * BM + wr * 64 + fr, col0 = u.pn * BM + wc * 32 + 8 * fq; const float inv = 1.0f / scale;
#pragma unroll
        for (int ai = 0; ai < 2; ++ai)
#pragma unroll
            for (int m = 0; m < 4; ++m) { const bf16_t* bp = hb + (size_t)(row0 + ai * HALF + m * 16) * DM + col0;
#pragma unroll
                for (int bj = 0; bj < 2; ++bj) { const u32x4 w = *(const u32x4*)(bp + bj * HALF);
                    acc[ai][bj][m][0] = (f32x4){bf_lo(w.x), bf_hi(w.x), bf_lo(w.y), bf_hi(w.y)} * inv; acc[ai][bj][m][1] = (f32x4){bf_lo(w.z), bf_hi(w.z), bf_lo(w.w), bf_hi(w.w)} * inv; } }
    }
    __device__ __forceinline__ void operator()(const f32x4 (&acc)[2][2][4][2], const Unit& u, int wr, int wc, int fr, int fq) const {
        asm volatile("" : "+v"(fr), "+v"(fq));
        const int row0 = u.pm * BM + wr * 64 + fr, col0 = u.pn * BM + wc * 32 + 8 * fq;
#pragma unroll
        for (int ai = 0; ai < 2; ++ai)
#pragma unroll
            for (int m = 0; m < 4; ++m) { const int row = row0 + ai * HALF + m * 16; bf16_t* hp = hb + (size_t)row * DM + col0; float sq = 0.f;
#pragma unroll
                for (int bj = 0; bj < 2; ++bj) { const f32x4 o0 = acc[ai][bj][m][0] * scale, o1 = acc[ai][bj][m][1] * scale;
                    sq += ((o0[0] * o0[0] + o0[1] * o0[1]) + (o0[2] * o0[2] + o0[3] * o0[3])) + ((o1[0] * o1[0] + o1[1] * o1[1]) + (o1[2] * o1[2] + o1[3] * o1[3]));
                    u32x4 w; w.x = cvt_pk_bf16(o0[0], o0[1]); w.y = cvt_pk_bf16(o0[2], o0[3]); w.z = cvt_pk_bf16(o1[0], o1[1]); w.w = cvt_pk_bf16(o1[2], o1[3]); *(u32x4*)(hp + bj * HALF) = w; }
                sq = xadd32(xadd16(sq));
                if (fq == 0) ssq_out[(size_t)row * 16 + u.pn * 4 + wc] = sq; }
    }
};
struct EpiMla {
    static constexpr bool PERM = false, AFTER_DRAIN = false, KEEP_ACC = false, HAS_INIT = false, HAS_PRE = false; __device__ __forceinline__ bool keep(const Unit&) const { return false; }
    bf16_t* Qb; bf16_t* Kb; bf16_t* Vb; const float* rope;
    __device__ __forceinline__ void operator()(const f32x4 (&acc)[2][2][4][2], const Unit& u, int wr, int wc, int fr, int fq) const {
        asm volatile("" : "+v"(fr), "+v"(fq));
        const int row0 = u.pm * BM + wr * 64 + fr;
#pragma unroll
        for (int bj = 0; bj < 2; ++bj) { const int cb = u.pn * BM + bj * HALF;
            if (cb >= 896) continue;
            const int g32 = (cb >> 5) + wc; const bool is_pe = (cb < 384) && (g32 % 3 == 2);
#pragma unroll
            for (int ai = 0; ai < 2; ++ai) {
            f32x4 csA[4], snA[4];
            if (is_pe) {
#pragma unroll
                for (int k = 0; k < 4; ++k) { const int row = row0 + ai * HALF + k * 16; const int pos = row < NPR ? (row & (SEQ - 1)) : SEQ + (row & 3);
                    csA[k] = *(const f32x4*)(rope + (size_t)pos * 32 + 4 * fq); snA[k] = *(const f32x4*)(rope + (size_t)pos * 32 + 16 + 4 * fq); } }
#pragma unroll
                for (int m = 0; m < 4; ++m) { const int row = row0 + ai * HALF + m * 16;
                    f32x4 v0 = acc[ai][bj][m][0], v1 = acc[ai][bj][m][1];
                    const int c0 = cb + wc * 32 + 4 * fq;
                    if (cb < 384) {
                        if (is_pe) { const f32x4 cs = csA[m], sn = snA[m];
                            const f32x4 a = v0 * cs - v1 * sn, b = v1 * cs + v0 * sn; v0 = a; v1 = b; }
                        v0 = v0 * ATT_C2; v1 = v1 * ATT_C2;
                        u32x2 w0, w1; w0.x = cvt_pk_bf16(v0[0], v0[1]); w0.y = cvt_pk_bf16(v0[2], v0[3]); w1.x = cvt_pk_bf16(v1[0], v1[1]); w1.y = cvt_pk_bf16(v1[2], v1[3]);
                        *(u32x2*)(Qb + (size_t)row * 384 + c0) = w0; *(u32x2*)(Qb + (size_t)row * 384 + c0 + 16) = w1;
                    } else if (cb < 640) {
                        const int kc = c0 - 384, kc1 = kc + 16;
                        u32x2 w0, w1; w0.x = cvt_pk_bf16(v0[0], v0[1]); w0.y = cvt_pk_bf16(v0[2], v0[3]); w1.x = cvt_pk_bf16(v1[0], v1[1]); w1.y = cvt_pk_bf16(v1[2], v1[3]);
                        *(u32x2*)(Kb + kt_off(row, kc >> 6, kc & 63)) = w0; *(u32x2*)(Kb + kt_off(row, kc1 >> 6, kc1 & 63)) = w1;
                    } else {
                        u32x2 w0, w1; w0.x = cvt_pk_bf16(v0[0], v0[1]); w0.y = cvt_pk_bf16(v0[2], v0[3]); w1.x = cvt_pk_bf16(v1[0], v1[1]); w1.y = cvt_pk_bf16(v1[2], v1[3]);
                        { const int vc = c0 - 640; *(u32x2*)(Vb + vt_off(row, vc >> 6, vc & 63)) = w0; *(u32x2*)(Vb + vt_off(row, (vc + 16) >> 6, (vc + 16) & 63)) = w1; }
                    }
                    asm volatile("" ::: "memory"); }
            }
        }
    }
};
struct EpiBranch {
    static constexpr bool PERM = true, AFTER_DRAIN = false, KEEP_ACC = true, HAS_INIT = false, HAS_PRE = false;
    const bf16_t* Z; bf16_t* mg;
    __device__ __forceinline__ bool keep(const Unit& u) const { return u.sub != 3; }
    __device__ __forceinline__ void operator()(f32x4 (&acc)[2][2][4][2], const Unit& u, int wr, int wc, int fr, int fq) const {
        asm volatile("" : "+v"(fr), "+v"(fq));
        const int row0 = u.pm * BM + wr * 64 + fr, col0 = u.pn * BM + wc * 32 + 8 * fq, sub = u.sub;
#pragma unroll
        for (int ai = 0; ai < 2; ++ai)
#pragma unroll
            for (int m = 0; m < 4; ++m) { const int row = row0 + ai * HALF + m * 16;
#pragma unroll
                for (int bj = 0; bj < 2; ++bj) { const int col = col0 + bj * HALF; const bf16_t* gp = Z + (size_t)row * INP + ZC_GATE + sub * DM + col;
                    const u32x4 gw = *(const u32x4*)gp;
                    f32x4 s0 = (f32x4){bf_lo(gw.x), bf_hi(gw.x), bf_lo(gw.y), bf_hi(gw.y)}, s1 = (f32x4){bf_lo(gw.z), bf_hi(gw.z), bf_lo(gw.w), bf_hi(gw.w)};
                    if (sub != 3) { const u32x4 gn = *(const u32x4*)(gp + DM);
                        s0[0] *= __builtin_amdgcn_rcpf(bf_lo(gn.x)); s0[1] *= __builtin_amdgcn_rcpf(bf_hi(gn.x)); s0[2] *= __builtin_amdgcn_rcpf(bf_lo(gn.y)); s0[3] *= __builtin_amdgcn_rcpf(bf_hi(gn.y));
                        s1[0] *= __builtin_amdgcn_rcpf(bf_lo(gn.z)); s1[1] *= __builtin_amdgcn_rcpf(bf_hi(gn.z)); s1[2] *= __builtin_amdgcn_rcpf(bf_lo(gn.w)); s1[3] *= __builtin_amdgcn_rcpf(bf_hi(gn.w));
                        acc[ai][bj][m][0] *= s0; acc[ai][bj][m][1] *= s1; }
                    else { const f32x4 v0 = acc[ai][bj][m][0] * s0, v1 = acc[ai][bj][m][1] * s1;
                        u32x4 w; w.x = cvt_pk_bf16(v0[0], v0[1]); w.y = cvt_pk_bf16(v0[2], v0[3]); w.z = cvt_pk_bf16(v1[0], v1[1]); w.w = cvt_pk_bf16(v1[2], v1[3]);
                        *(u32x4*)(mg + (size_t)row * DM + col) = w; } }
                if (m & 1) asm volatile("" ::: "memory"); }
    }
};

struct NoHook { static constexpr bool ON = false; __device__ __forceinline__ void operator()() const {} };
template <class Epi, class Sched, bool ALIGN_EPI = false, bool SP2 = false, class Hook = NoHook>
__device__ __forceinline__ void gemm_phase(PG8_LAS unsigned char* lds, const Gemm g, const Sched& S, const Epi& E, const Hook& hook = Hook()) {
    static_assert(!Hook::ON || SP2, "the hook variant is written for the SP2 prologue");
    int tid_ = threadIdx.x; asm volatile("" : "+v"(tid_));
    const int tid = tid_, wid = __builtin_amdgcn_readfirstlane(tid >> 6), lane = tid & 63, wr = wid >> 2, wc = wid & 3, fr = lane & 15, fq = lane >> 4;
    const int K = g.K, nt = K / BK, lda = g.lda, ldb = g.ldb;
    unsigned voffA[2], voffB[2];
#pragma unroll
    for (int i = 0; i < 2; ++i) { int R, C; stage_rc(tid * 16 + i * 8192, R, C); const int Rb = Epi::PERM ? ((R & ~31) + perm32(R & 31)) : R;
        voffA[i] = (unsigned)(R * lda + C) * 2u; voffB[i] = (unsigned)(Rb * ldb + C) * 2u; }
    const size_t kstep = (size_t)(BK * 2);
    const size_t hstepA = (size_t)HALF * lda * 2, hstepB = (size_t)HALF * ldb * 2;
    const unsigned ldsw = (unsigned)wid * 1024u;
    const int aoff = lds_byte(wr * 64 + fr, fq * 8), boff = lds_byte(wc * 32 + fr, fq * 8);
#define PG8_SA(b, h) (((b) * 2 + (h)) * HTB)
#define PG8_SB(b, h) ((4 + (b) * 2 + (h)) * HTB)
#define PG8_STAGE(bufoff, gbase, voff) do { _Pragma("unroll") for (int _i = 0; _i < 2; ++_i) \
        __builtin_amdgcn_global_load_lds((const unsigned*)((const char*)(gbase) + (voff)[_i]), (PG8_LAS unsigned*)(lds + (bufoff) + ldsw + _i * 8192), 16, 0, 0); } while (0)
#define PG8_LDA(dst, b, h) do { _Pragma("unroll") for (int m = 0; m < 4; ++m) _Pragma("unroll") for (int k = 0; k < 2; ++k) dst[m][k] = *(const PG8_LAS bf16x8*)(lds + PG8_SA(b, h) + aoff + m * 2048 + k * 1024); } while (0)
#define PG8_LDB(dst, b, h) do { _Pragma("unroll") for (int n = 0; n < 2; ++n) _Pragma("unroll") for (int k = 0; k < 2; ++k) dst[n][k] = *(const PG8_LAS bf16x8*)(lds + PG8_SB(b, h) + boff + n * 2048 + k * 1024); } while (0)
#define PG8_MMA(ai, bj, At, Bt) do { __builtin_amdgcn_s_setprio(1); _Pragma("unroll") for (int m = 0; m < 4; ++m) _Pragma("unroll") for (int n = 0; n < 2; ++n) _Pragma("unroll") for (int k = 0; k < 2; ++k) \
        acc[ai][bj][m][n] = __builtin_amdgcn_mfma_f32_16x16x32_bf16(Bt[n][k], At[m][k], acc[ai][bj][m][n], 0, 0, 0); __builtin_amdgcn_s_setprio(0); } while (0)
#define PG8_WAIT_V(n) asm volatile("s_waitcnt vmcnt(" #n ")" ::: "memory")
#define PG8_WAIT_L(n) asm volatile("s_waitcnt lgkmcnt(" #n ")" ::: "memory")
#define PG8_BAR __builtin_amdgcn_s_barrier()
#define PG8_SCHED __builtin_amdgcn_sched_barrier(0)
    Unit cur, nxt; int ui = 0;
    if (!S.next(0, cur)) { if constexpr (Hook::ON) hook(); return; }
    if constexpr (Hook::ON) {
        const char* hA = S.a_ptr(cur); const char* hB = S.b_ptr(cur); S.a_ready(cur);
        PG8_STAGE(PG8_SB(0, 0), hB, voffB); PG8_STAGE(PG8_SB(0, 1), hB + hstepB, voffB); PG8_STAGE(PG8_SA(0, 0), hA, voffA); PG8_STAGE(PG8_SA(0, 1), hA + hstepA, voffA);
        hook();
    }
    f32x4 acc[2][2][4][2];
#pragma unroll
    for (int a = 0; a < 2; ++a)
#pragma unroll
        for (int b = 0; b < 2; ++b)
#pragma unroll
            for (int m = 0; m < 4; ++m)
#pragma unroll
                for (int n = 0; n < 2; ++n) acc[a][b][m][n] = (f32x4){0.f, 0.f, 0.f, 0.f};
    if constexpr (Epi::HAS_INIT) E.init(acc, cur, wr, wc, fr, fq);
    f32x4 pq0[2]; if constexpr (Epi::HAS_PRE) E.pre_load(cur, wr, wc, fr, fq, pq0);
    bf16x8 At[4][2], B0[2][2], B1[2][2];
    const char* cA = S.a_ptr(cur); const char* cB = S.b_ptr(cur);
    if constexpr (!Hook::ON) S.a_ready(cur);
    if constexpr (SP2) {
        if constexpr (!Hook::ON) { PG8_STAGE(PG8_SB(0, 0), cB, voffB); PG8_STAGE(PG8_SB(0, 1), cB + hstepB, voffB); PG8_STAGE(PG8_SA(0, 0), cA, voffA); PG8_STAGE(PG8_SA(0, 1), cA + hstepA, voffA); }
        if (wr == 1) PG8_BAR;
        PG8_WAIT_V(2); PG8_BAR;
        PG8_STAGE(PG8_SB(1, 0), cB + kstep, voffB); PG8_STAGE(PG8_SA(1, 0), cA + kstep, voffA); PG8_STAGE(PG8_SB(1, 1), cB + hstepB + kstep, voffB);
        PG8_WAIT_V(6); PG8_BAR;
    } else {
        PG8_STAGE(PG8_SB(0, 0), cB, voffB); PG8_STAGE(PG8_SA(0, 0), cA, voffA); PG8_STAGE(PG8_SB(0, 1), cB + hstepB, voffB); PG8_STAGE(PG8_SA(0, 1), cA + hstepA, voffA);
        if (wr == 1) PG8_BAR;
        PG8_WAIT_V(4); PG8_BAR;
        PG8_STAGE(PG8_SB(1, 0), cB + kstep, voffB); PG8_STAGE(PG8_SA(1, 0), cA + kstep, voffA); PG8_STAGE(PG8_SB(1, 1), cB + hstepB + kstep, voffB);
        PG8_WAIT_V(6); PG8_BAR;
    }
    if constexpr (Epi::HAS_PRE) E.pre_commit(pq0, wr, wc, fr, fq, 0);
    for (;;) {
        const bool has_next = S.next(ui + 1, nxt);
        const char* nA = has_next ? S.a_ptr(nxt) : cA; const char* nB = has_next ? S.b_ptr(nxt) : cB;
#pragma unroll 1
        for (int t = 0; t < nt; t += 2) {
            const bool last = (t == nt - 2);
            const char* a1 = cA + (size_t)(t + 1) * kstep;
            const char* a2 = last ? nA : cA + (size_t)(t + 2) * kstep; const char* b2 = last ? nB : cB + (size_t)(t + 2) * kstep;
            const char* a3 = a2 + kstep; const char* b3 = b2 + kstep;
            if (last && has_next) S.a_ready(nxt);
            if constexpr (SP2) {
            PG8_LDB(B0, 0, 0); PG8_LDB(B1, 0, 1); PG8_SCHED; PG8_LDA(At, 0, 0); PG8_STAGE(PG8_SA(1, 1), a1 + hstepA, voffA);
            PG8_WAIT_V(8); PG8_WAIT_L(0); PG8_BAR; PG8_MMA(0, 0, At, B0); PG8_MMA(0, 1, At, B1); PG8_BAR; PG8_SCHED;
            PG8_LDA(At, 0, 1); PG8_STAGE(PG8_SB(0, 0), b2, voffB); PG8_STAGE(PG8_SB(0, 1), b2 + hstepB, voffB); PG8_STAGE(PG8_SA(0, 0), a2, voffA);
            PG8_WAIT_V(8); PG8_WAIT_L(0); PG8_BAR; PG8_MMA(1, 0, At, B0); PG8_MMA(1, 1, At, B1); PG8_BAR; PG8_SCHED;
            PG8_LDB(B0, 1, 0); PG8_LDB(B1, 1, 1); PG8_SCHED; PG8_LDA(At, 1, 0); PG8_STAGE(PG8_SA(0, 1), a2 + hstepA, voffA);
            PG8_WAIT_V(8); PG8_WAIT_L(0); PG8_BAR; PG8_MMA(0, 0, At, B0); PG8_MMA(0, 1, At, B1); PG8_BAR; PG8_SCHED;
            PG8_LDA(At, 1, 1); PG8_STAGE(PG8_SB(1, 0), b3, voffB); PG8_STAGE(PG8_SB(1, 1), b3 + hstepB, voffB); PG8_STAGE(PG8_SA(1, 0), a3, voffA);
            PG8_WAIT_V(8); PG8_WAIT_L(0); PG8_BAR; PG8_MMA(1, 0, At, B0); PG8_MMA(1, 1, At, B1); PG8_BAR; PG8_SCHED;
            } else {
            PG8_LDB(B0, 0, 0); PG8_SCHED; PG8_LDA(At, 0, 0); PG8_STAGE(PG8_SA(1, 1), a1 + hstepA, voffA);
            PG8_WAIT_L(8); PG8_BAR; PG8_WAIT_L(0); PG8_MMA(0, 0, At, B0); PG8_BAR; PG8_SCHED;
            PG8_LDB(B1, 0, 1); PG8_STAGE(PG8_SB(0, 0), b2, voffB);
            PG8_BAR; PG8_WAIT_L(0); PG8_MMA(0, 1, At, B1); PG8_BAR;
            PG8_LDA(At, 0, 1); PG8_STAGE(PG8_SA(0, 0), a2, voffA);
            PG8_BAR; PG8_WAIT_L(0); PG8_MMA(1, 0, At, B0); PG8_BAR; PG8_SCHED;
            PG8_STAGE(PG8_SB(0, 1), b2 + hstepB, voffB);
            PG8_WAIT_V(6); PG8_BAR; PG8_MMA(1, 1, At, B1); PG8_BAR;
            PG8_LDB(B0, 1, 0); PG8_SCHED; PG8_LDA(At, 1, 0); PG8_STAGE(PG8_SA(0, 1), a2 + hstepA, voffA);
            PG8_WAIT_L(8); PG8_BAR; PG8_WAIT_L(0); PG8_MMA(0, 0, At, B0); PG8_BAR; PG8_SCHED;
            PG8_LDB(B1, 1, 1); PG8_STAGE(PG8_SB(1, 0), b3, voffB);
            PG8_BAR; PG8_WAIT_L(0); PG8_MMA(0, 1, At, B1); PG8_BAR;
            PG8_LDA(At, 1, 1); PG8_STAGE(PG8_SA(1, 0), a3, voffA);
            PG8_BAR; PG8_WAIT_L(0); PG8_MMA(1, 0, At, B0); PG8_BAR; PG8_SCHED;
            PG8_STAGE(PG8_SB(1, 1), b3 + hstepB, voffB);
            PG8_WAIT_V(6); PG8_BAR; PG8_MMA(1, 1, At, B1); PG8_BAR;
            }
        }
        if constexpr (ALIGN_EPI) { if (wr == 0) PG8_BAR; }
        f32x4 pq[2];
        if constexpr (Epi::HAS_PRE) { if (has_next) E.pre_load(nxt, wr, wc, fr, fq, pq); }
        if constexpr (!Epi::AFTER_DRAIN) { if constexpr (Epi::HAS_PRE) E(acc, cur, wr, wc, fr, fq, ui & 1); else E(acc, cur, wr, wc, fr, fq); S.done(cur); }
        if constexpr (Epi::HAS_PRE) { if (has_next) E.pre_commit(pq, wr, wc, fr, fq, (ui + 1) & 1); }
        if (!has_next) break;
        if (!(Epi::KEEP_ACC && E.keep(cur))) {
#pragma unroll
        for (int a = 0; a < 2; ++a)
#pragma unroll
            for (int b = 0; b < 2; ++b)
#pragma unroll
                for (int m = 0; m < 4; ++m)
#pragma unroll
                    for (int n = 0; n < 2; ++n) acc[a][b][m][n] = (f32x4){0.f, 0.f, 0.f, 0.f};
        if constexpr (Epi::HAS_INIT) E.init(acc, nxt, wr, wc, fr, fq);
        }
        cur = nxt; cA = nA; cB = nB; ++ui;
        if constexpr (ALIGN_EPI) { if (wr == 1) PG8_BAR; }
    }
    PG8_WAIT_V(0);
    if constexpr (!ALIGN_EPI) { if (wr == 0) PG8_BAR; }
    PG8_BAR;
    if constexpr (Epi::AFTER_DRAIN) { E.fused(acc, cur, wr, wc, fr, fq, lds, wid, lane); S.done(cur); }
#undef PG8_SA
#undef PG8_SB
#undef PG8_STAGE
#undef PG8_LDA
#undef PG8_LDB
#undef PG8_MMA
#undef PG8_WAIT_V
#undef PG8_WAIT_L
#undef PG8_BAR
#undef PG8_SCHED
}
}

typedef unsigned short bf16;
typedef unsigned v4u __attribute__((ext_vector_type(4)));
typedef unsigned v2u __attribute__((ext_vector_type(2)));
typedef float f32x4 __attribute__((ext_vector_type(4)));
typedef float f32x2 __attribute__((ext_vector_type(2)));
typedef short bf16x8 __attribute__((ext_vector_type(8)));
typedef GAS unsigned gu32;
typedef GAS unsigned long long gu64;
#define RLX_AGENT __ATOMIC_RELAXED, __HIP_MEMORY_SCOPE_AGENT
#define LDS_WAIT() asm volatile("s_waitcnt lgkmcnt(0)" ::: "memory")
#define VM_WAIT() asm volatile("s_waitcnt vmcnt(0)" ::: "memory")
__device__ __forceinline__ unsigned f2bf(float f) { unsigned u = __builtin_bit_cast(unsigned, f); return (u + 0x7fffu + ((u >> 16) & 1u)) >> 16; }
__device__ __forceinline__ unsigned pk2(float lo, float hi) { return f2bf(lo) | (f2bf(hi) << 16); }
__device__ __forceinline__ float bflo(unsigned w) { return __uint_as_float(w << 16); }
__device__ __forceinline__ float bfhi(unsigned w) { return __uint_as_float(w & 0xffff0000u); }
__device__ __forceinline__ float gelu_tanh(float x) {
    const float inner = 0.7978845608028654f * (x + 0.044715f * x * x * x);
    return x * __builtin_amdgcn_rcpf(1.f + __builtin_amdgcn_exp2f(-2.f * 1.4426950408889634f * inner));
}
__device__ __forceinline__ float silu1(float x) { return x * __builtin_amdgcn_rcpf(1.f + __builtin_amdgcn_exp2f(-1.4426950408889634f * x)); }
__device__ __forceinline__ float sigm1(float x) { return __builtin_amdgcn_rcpf(1.f + __builtin_amdgcn_exp2f(-1.4426950408889634f * x)); }
__device__ __forceinline__ float wave_sum(float v) {
    return xadd32(xadd16(xadd8(xadd4(xadd2(xadd1(v))))));
}

#define XB_TMO      128
#define XB_XCNT(j)  (256  + 64 * (j))
#define XB_XSUB(j)  (1280 + 64 * (j))
#define XB_XGEN(j)  (2304 + 64 * (j))
#define XB_TOP      3328
#define XB_TOPGEN   3392
#define XCD_BAR_WORDS 3456
#define XB_SPIN_CAP (1u << 18)

__device__ __forceinline__ unsigned xb_ld(unsigned* p)              { return __hip_atomic_load(p, __ATOMIC_RELAXED, __HIP_MEMORY_SCOPE_AGENT); }
__device__ __forceinline__ unsigned xb_add(unsigned* p, unsigned v) { return __hip_atomic_fetch_add(p, v, __ATOMIC_RELAXED, __HIP_MEMORY_SCOPE_AGENT); }
__device__ __forceinline__ unsigned xb_xcc_id() { return (unsigned)__builtin_amdgcn_s_getreg((3 << 11) | 20) & 0xFu; }
#define XB_SPIN(cond, bar) do { unsigned _sp = 0; while (cond) { __builtin_amdgcn_s_sleep(1); \
    if ((++_sp & 255u) == 0u) { if (xb_ld(&(bar)[XB_TMO])) break; if (_sp > XB_SPIN_CAP) { atomicAdd(&(bar)[XB_TMO], 1u); break; } } } } while (0)

struct XcdBarrier {
    unsigned* bar; unsigned x;
    volatile LAS unsigned* st;
};

__device__ __forceinline__ XcdBarrier xcd_barrier_post(unsigned* bar, volatile LAS unsigned* st) {
    XcdBarrier b; b.bar = bar; b.x = xb_xcc_id(); b.st = st;
    if (threadIdx.x == 0) (void)xb_add(&bar[XB_XCNT(b.x)], 1u);
    return b;
}
__device__ __forceinline__ void xcd_barrier_complete(unsigned* bar, unsigned x, unsigned& nloc, unsigned& nx) {
    const unsigned G = gridDim.x * gridDim.y * gridDim.z;
    unsigned sum, cnt, mine, sp = 0u;
    for (;;) {
        sum = 0u; cnt = 0u; mine = 0u;
#pragma unroll
        for (unsigned j = 0; j < 16; ++j) { const unsigned c = xb_ld(&bar[XB_XCNT(j)]); sum += c; cnt += (c > 0u) ? 1u : 0u; mine = (j == x) ? c : mine; }
        if (sum == G) break;
        __builtin_amdgcn_s_sleep(1);
        if ((++sp & 255u) == 0u) { if (xb_ld(&bar[XB_TMO])) break; if (sp > XB_SPIN_CAP) { atomicAdd(&bar[XB_TMO], 1u); break; } }
    }
    nloc = mine > 0u ? mine : 1u; nx = cnt > 0u ? cnt : 1u;
}

__device__ __forceinline__ void xcd_barrier(const XcdBarrier& b) {
    asm volatile("s_waitcnt vmcnt(0)" ::: "memory");
    __syncthreads();
    if (threadIdx.x == 0) {
        unsigned* bar = b.bar;
        __builtin_amdgcn_s_waitcnt(0);
        unsigned nloc = b.st[0], nx = b.st[1];
        if (nloc == 0u) { xcd_barrier_complete(bar, b.x, nloc, nx); b.st[0] = nloc; b.st[1] = nx; }
        const unsigned old = xb_add(&bar[XB_XSUB(b.x)], 1u);
        const unsigned gen = old / nloc;
        if (old + 1u == (gen + 1u) * nloc) {
            __builtin_amdgcn_fence(__ATOMIC_RELEASE, "agent");
            asm volatile("s_waitcnt vmcnt(0)" ::: "memory");
            const unsigned og = xb_add(&bar[XB_TOP], 1u);
            const unsigned tg = og / nx;
            if (og + 1u == (tg + 1u) * nx) xb_add(&bar[XB_TOPGEN], 1u);
            else XB_SPIN(xb_ld(&bar[XB_TOPGEN]) == tg, bar);
            __builtin_amdgcn_fence(__ATOMIC_ACQUIRE, "agent");
            xb_add(&bar[XB_XGEN(b.x)], 1u);
            asm volatile("s_waitcnt vmcnt(0)" ::: "memory");
        } else {
            XB_SPIN(xb_ld(&bar[XB_XGEN(b.x)]) == gen, bar);
            __builtin_amdgcn_fence(__ATOMIC_ACQUIRE, "agent");
            asm volatile("s_waitcnt vmcnt(0)" ::: "memory");
        }
    }
    __syncthreads();
}


struct Frame {
    LAS unsigned char* lds;
    volatile LAS unsigned* MISC;
    gu32* ctl;
    int tid, lane, wave;
    int vcu, G, bid;
    unsigned char* ws; float* out;
};

__device__ __forceinline__ void tr_item_wg(const float* W, int ldw, int k0, int n0, int nmax, bf16* dst, int dst_ld, int mode, int row_off, int dst_col0, const float* gain, LAS unsigned char* scr, int tid) {
    const int wave = tid >> 6, lane = tid & 63; const int n = n0 + 4 * lane; const bool ok = n < nmax;
    const float* src = W + (size_t)(k0 + 8 * wave) * ldw + (ok ? n : n0);
    f32x4 v[8];
#pragma unroll
    for (int j = 0; j < 8; ++j) v[j] = *(const f32x4*)(src + (size_t)j * ldw);
    if (gain) {
#pragma unroll
        for (int j = 0; j < 8; ++j) v[j] = v[j] * gain[k0 + 8 * wave + j]; }
#pragma unroll
    for (int e = 0; e < 4; ++e) { v2u a, b; a.x = pk2(v[0][e], v[1][e]); a.y = pk2(v[2][e], v[3][e]); b.x = pk2(v[4][e], v[5][e]); b.y = pk2(v[6][e], v[7][e]);
        LAS unsigned char* p = scr + (4 * lane + e) * 136 + 16 * wave; *(LAS v2u*)p = a; *(LAS v2u*)(p + 8) = b; }
    __syncthreads();
#pragma unroll
    for (int i = 0; i < 4; ++i) { const int q = tid + 512 * i, row = q >> 3, c = q & 7; const LAS unsigned char* p = scr + row * 136 + 16 * c;
        const v2u a = *(const LAS v2u*)p, b = *(const LAS v2u*)(p + 8); const int nn = n0 + row;
        if (nn < nmax) { const int drow = mode ? ((nn >> 7) * 256 + row_off + (nn & 127)) : (row_off + nn); v4u o; o.x = a.x; o.y = a.y; o.z = b.x; o.w = b.y;
            *(GAS v4u*)(dst + (size_t)drow * dst_ld + dst_col0 + 8 * c) = o; } }
    __syncthreads();
}
struct InRaw { const float* p[33]; };
struct InPtrs { const LAS unsigned long long* tab;
    __device__ __forceinline__ const float* p(int i) const { const unsigned long long v = tab[i]; const unsigned lo = __builtin_amdgcn_readfirstlane((unsigned)v), hi = __builtin_amdgcn_readfirstlane((unsigned)(v >> 32));
        return (const float*)(const GAS float*)(((unsigned long long)hi << 32) | lo); } };

__host__ __device__ constexpr int conv_seg_items(int seg) { return seg == 6 ? 400 : (seg == 7 || seg == 8) ? 64 : seg == 9 ? 12 : 176; }
__device__ __forceinline__ void conv_item(Frame& F, const InPtrs& I, int L, int seg, int it, LAS unsigned char* scr, int tid) {
    unsigned char* wl = F.ws + WS_WL + (size_t)L * WL_STRIDE;
    if (seg <= 5) { const int f = seg >= 3, s = seg - 3 * f;
        if (s < 2) { constexpr int NB = DFF / 256; const int kb = it / NB, nb = it % NB;
            tr_item_wg(I.p(f ? (s ? 30 : 29) : (s ? 9 : 8)) + (size_t)L * DM * DFF, DFF, kb * 64, nb * 256, DFF, (bf16*)(wl + (f ? WL_GU2 : WL_GU1)), DM, 1, s * 128, kb * 64, I.p(f ? 28 : 7) + L * DM, scr, tid); }
        else { constexpr int NBD = DM / 256; const int kb = it / NBD, nb = it % NBD;
            tr_item_wg(I.p(f ? 31 : 10) + (size_t)L * DFF * DM, DM, kb * 64, nb * 256, DM, (bf16*)(wl + (f ? WL_D2 : WL_D1)), DFF, 0, 0, kb * 64, nullptr, scr, tid); } }
    else if (seg == 6) { constexpr int NB = (INC + 255) / 256; const int kb = it / NB, nb = it % NB;
        tr_item_wg(I.p(12) + (size_t)L * DM * INC, INC, kb * 64, nb * 256, INC, (bf16*)(wl + WL_IN), DM, 0, 0, kb * 64, I.p(11) + L * DM, scr, tid); }
    else if (seg == 7) { constexpr int NB = DM / 256, NI1 = (BRW / 64) * NB; const int i = it / NI1, r = it % NI1, kb = r / NB, nb = r % NB;
        tr_item_wg(I.p(26) + ((size_t)L * 4 + i) * BRW * DM, DM, kb * 64, nb * 256, DM, (bf16*)(wl + WL_BR) + (size_t)i * DM * BRW, BRW, 0, 0, kb * 64, nullptr, scr, tid); }
    else if (seg == 8) { constexpr int NB = DM / 256; const int kb = it / NB, nb = it % NB;
        tr_item_wg(I.p(27) + (size_t)L * DM * DM, DM, kb * 64, nb * 256, DM, (bf16*)(wl + WL_O), DM, 0, 0, kb * 64, nullptr, scr, tid); }
    else { bf16* Wc = (bf16*)(F.ws + WS_WCAT + (size_t)L * WCAT_BYTES); constexpr int NIQ = (256 / 64) * 2, NIK = 128 / 64;
        if (it < NIQ) { const int kb = it / 2, nb = it % 2; tr_item_wg(I.p(19) + (size_t)L * 256 * 384, 384, kb * 64, nb * 256, 384, Wc, 384, 0, 0, kb * 64, I.p(17) + L * 256, scr, tid); }
        else { const int r = it - NIQ, which = r >= NIK, kb = which ? r - NIK : r;
            tr_item_wg(I.p(which ? 21 : 20) + (size_t)L * 128 * 256, 256, kb * 64, 0, 256, Wc, 384, 0, which ? 640 : 384, 256 + kb * 64, nullptr, scr, tid); } }
}
struct ConvJob { int n; unsigned char js[8]; };
__host__ __device__ constexpr ConvJob conv_jobs(int list) {
    return list == 0 ? ConvJob{2, {0x00, 0x01}}
         : list == 1 ? ConvJob{2, {0x02, 0x06}}
         : list == 2 ? ConvJob{5, {0x09, 0x07, 0x08, 0x03, 0x04}}
         : list == 3 ? ConvJob{3, {0x05, 0x10, 0x11}}
         : list == 4 ? ConvJob{2, {0x12, 0x16}}
         :             ConvJob{6, {0x19, 0x17, 0x18, 0x13, 0x14, 0x15}};
}
template <int LIST> __device__ __forceinline__ void conv_list_item(Frame& F, const InPtrs& I, int it, LAS unsigned char* scr, int tid, bool& done) {
    constexpr ConvJob J = conv_jobs(LIST); int base = 0; done = true;
#pragma unroll
    for (int k = 0; k < J.n; ++k) { const int cnt = conv_seg_items(J.js[k] & 15);
        if (it >= base && it < base + cnt) { conv_item(F, I, J.js[k] >> 4, J.js[k] & 15, it - base, scr, tid); done = false; }
        base += cnt; }
}
template <int LIST> __device__ __forceinline__ void conv_drain_queue(Frame& F, const InPtrs& I, gu32* qh) {
    LAS unsigned char* scr = F.lds + RING_OFF;
    __syncthreads(); if (F.tid == 0) F.MISC[1] = __hip_atomic_fetch_add(qh, 1u, RLX_AGENT); __syncthreads();
    int it = (int)F.MISC[1];
    for (;;) { unsigned nx = 0u; if (F.tid == 0) nx = __hip_atomic_fetch_add(qh, 1u, RLX_AGENT);
        bool done; conv_list_item<LIST>(F, I, it, scr, F.tid, done); if (done) break;
        if (F.tid == 0) F.MISC[1] = nx; __syncthreads(); it = (int)F.MISC[1]; }
}
#ifndef PROSKIP
#define PROSKIP 0
#endif
__device__ __forceinline__ void p0_prologue(Frame& F, const InPtrs& I, const bool ex = false) {
    const int gw = F.vcu * NWAVES + F.wave, NGW = F.G * NWAVES, lane = F.lane, tid = F.tid;
    LAS unsigned char* scr = F.lds + RING_OFF;
    if (!(ex && (PROSKIP & 1))) { constexpr int NIT = 2 * 176;
        for (int it = F.vcu; it < NIT; it += F.G) { bool d; conv_list_item<0>(F, I, it, scr, tid, d); } }
    for (int L = 0; L < 2; ++L) {
        {
            const float* W = I.p(15) + (size_t)L * 4 * 128 * 128; bf16* Wt = (bf16*)(F.ws + WS_WSB) + (size_t)L * 4 * 128 * 128;
            for (int e = (gw * 64 + lane) * 4; e < 4 * 128 * 128; e += NGW * 64 * 4) { const f32x4 v = *(const f32x4*)(W + e); const int i = (e >> 7) & 127, j = e & 127;
                v2u o; o.x = pk2(j <= i ? v[0] : 0.f, j + 1 <= i ? v[1] : 0.f); o.y = pk2(j + 2 <= i ? v[2] : 0.f, j + 3 <= i ? v[3] : 0.f); *(v2u*)(Wt + e) = o; }
        }
    }
    if (!(ex && (PROSKIP & 2))) {
        float* tab = (float*)(F.ws + WS_ROPE);
        for (int e = gw * 64 + lane; e < (SEQ + TS) * 16; e += NGW * 64) { const int pos = e >> 4, i = e & 15;
            const float inv = powf(10000.0f, -(float)i / 16.0f); const float ang = (float)pos * inv; tab[pos * 32 + i] = cosf(ang); tab[pos * 32 + 16 + i] = sinf(ang); }
    }
    if (!(ex && (PROSKIP & 4))) {
        bf16* hb = (bf16*)(F.ws + WS_HB); float* ssq = (float*)(F.ws + WS_SSQ);
        const float* xa = I.p(0); const float* xb = I.p(1);
        f32x4 cur[4], nxt[4];
        if (gw < MROWS) { const GAS f32x4* xp = (const GAS f32x4*)(gw < NPR ? xa + (size_t)gw * DM : xb + (size_t)(gw - NPR) * DM) + lane;
#pragma unroll
            for (int j = 0; j < 4; ++j) cur[j] = xp[64 * j]; }
        for (int m = gw; m < MROWS; m += NGW) { const int m2 = m + NGW;
            if (m2 < MROWS) { const GAS f32x4* xp = (const GAS f32x4*)(m2 < NPR ? xa + (size_t)m2 * DM : xb + (size_t)(m2 - NPR) * DM) + lane;
#pragma unroll
                for (int j = 0; j < 4; ++j) nxt[j] = xp[64 * j]; }
            GAS v2u* hp = (GAS v2u*)(hb + (size_t)m * DM) + lane; float s = 0.f;
#pragma unroll
            for (int j = 0; j < 4; ++j) { const f32x4 v = cur[j]; s += (v.x * v.x + v.y * v.y) + (v.z * v.z + v.w * v.w); v2u o; o.x = pk2(v.x, v.y); o.y = pk2(v.z, v.w); hp[64 * j] = o; }
            s = wave_sum(s); if (lane < 16) ssq[(size_t)m * 16 + lane] = lane == 0 ? s : 0.f;
#pragma unroll
            for (int j = 0; j < 4; ++j) cur[j] = nxt[j]; }
    }
}

__device__ __forceinline__ f32x4 ld4bf(const bf16* p) { const v2u w = *(const v2u*)p; return (f32x4){bflo(w.x), bfhi(w.x), bflo(w.y), bfhi(w.y)}; }
__device__ __forceinline__ void st4bf(bf16* p, f32x4 v) { v2u o; o.x = pk2(v[0], v[1]); o.y = pk2(v[2], v[3]); *(v2u*)p = o; }
__device__ __forceinline__ f32x4 glu4(const bf16* Zr, int c) { const f32x4 a = ld4bf(Zr + ZC_DV + c), g = ld4bf(Zr + ZC_DG + c); return (f32x4){a[0] * sigm1(g[0]), a[1] * sigm1(g[1]), a[2] * sigm1(g[2]), a[3] * sigm1(g[3])}; }

__device__ __forceinline__ void p_prep(Frame& F, const InPtrs& I, int L) {
    const bf16* Z = (const bf16*)(F.ws + WS_Z); bf16* YS = (bf16*)(F.ws + WS_YS); bf16* QL = (bf16*)(F.ws + WS_QL); bf16* KB = (bf16*)(F.ws + WS_KB);
    float* out = F.out; const float* rope = (const float*)(F.ws + WS_ROPE);
    const int gw = F.vcu * NWAVES + F.wave, NGW = F.G * NWAVES, lane = F.lane, wave = F.wave;
    {
        const float* kvg = I.p(18) + L * KVR; const float* scw = I.p(13) + L * 3 * BRW; const float* sta = I.p(5) + (size_t)L * NSEQ_S * 2 * BRW;
        const int c = 4 * lane;
        const f32x4 w0 = *(const f32x4*)(scw + c), w1 = *(const f32x4*)(scw + BRW + c), w2 = *(const f32x4*)(scw + 2 * BRW + c);
        const f32x2 kg = *(const f32x2*)(kvg + 2 * lane);
        const bool deal = (F.G == 256); const int nit = deal ? (F.vcu >= 128 ? 16 : (F.vcu < 64 ? 1 : 0)) : (MROWS + NGW - 1 - gw) / NGW;
#define PREP_ROW(it_) (deal ? ((F.vcu >= 128 ? (F.vcu - 128) * 16 + (it_) : 2048 + F.vcu) * 8 + wave) : gw + (it_) * NGW)
        struct RowIn { v2u cq, ah0, ac0, ah1, ac1, ah2, ac2, ab; unsigned ckv; unsigned short k1, k2; };
        auto load_row = [&](int r) { RowIn x; const bf16* Zr = Z + (size_t)r * INP; const bool pr = r < NPR; const int t = pr ? (r & (SEQ - 1)) : (r & 3);
            const bf16* Z1 = Zr - (t >= 1 ? INP : 0); const bf16* Z2 = Zr - (t >= 2 ? 2 * INP : 0);
            x.cq = *(const v2u*)(Zr + ZC_CQ + c); x.ckv = *(const unsigned*)(Zr + ZC_CKV + 2 * lane); x.k1 = Zr[ZC_CKR + (lane & 15)]; x.k2 = Zr[ZC_CKR + 16 + (lane & 15)];
            x.ah0 = *(const v2u*)(Zr + ZC_AH + c); x.ac0 = *(const v2u*)(Zr + ZC_AC + c); x.ah1 = *(const v2u*)(Z1 + ZC_AH + c); x.ac1 = *(const v2u*)(Z1 + ZC_AC + c);
            x.ah2 = *(const v2u*)(Z2 + ZC_AH + c); x.ac2 = *(const v2u*)(Z2 + ZC_AC + c); x.ab = *(const v2u*)(Zr + ZC_AB + c); return x; };
        auto up4 = [](v2u w) { return (f32x4){bflo(w.x), bfhi(w.x), bflo(w.y), bfhi(w.y)}; };
        RowIn cur, nxt; if (nit > 0) cur = load_row(PREP_ROW(0)); nxt = cur; if (nit > 1) nxt = load_row(PREP_ROW(1));
        for (int it = 0; it < nit; ++it) { const int r = PREP_ROW(it);
            RowIn nx2 = nxt; if (it + 2 < nit) nx2 = load_row(PREP_ROW(it + 2));
            const bool pr = r < NPR; const int t = pr ? (r & (SEQ - 1)) : (r & 3); const int rs_ = r - NPR; const int n = rs_ >> 2; const int pos = pr ? t : SEQ + t;
            { const f32x4 x = up4(cur.cq); const float ss = wave_sum((x[0] * x[0] + x[1] * x[1]) + (x[2] * x[2] + x[3] * x[3]));
              const float rs = __builtin_amdgcn_rsqf(ss * (1.0f / 256.0f) + RMS_EPS); st4bf(QL + (size_t)r * 384 + c, x * rs); }
            { const unsigned w = cur.ckv; const float x0 = bflo(w), x1 = bfhi(w); const float ss = wave_sum(x0 * x0 + x1 * x1);
              const float rs = __builtin_amdgcn_rsqf(ss * (1.0f / 128.0f) + RMS_EPS); const float l0 = x0 * rs * kg[0], l1 = x1 * rs * kg[1];
              float* lo = out + (pr ? OFF_LATP + ((size_t)L * NPR + r) * KVR : OFF_LATS + ((size_t)L * NSR + rs_) * KVR) + 2 * lane; *(f32x2*)lo = (f32x2){l0, l1};
              *(unsigned*)(QL + (size_t)r * 384 + 256 + 2 * lane) = pk2(l0, l1); }
            if (lane < 16) { const float x1 = __uint_as_float((unsigned)cur.k1 << 16), x2 = __uint_as_float((unsigned)cur.k2 << 16);
              const float cs = rope[(size_t)pos * 32 + lane], sn = rope[(size_t)pos * 32 + 16 + lane]; const float o1 = x1 * cs - x2 * sn, o2 = x2 * cs + x1 * sn;
              float* ko = out + (pr ? OFF_KRP + ((size_t)L * NPR + r) * QKR : OFF_KRS + ((size_t)L * NSR + rs_) * QKR); ko[lane] = o1; ko[16 + lane] = o2;
              const bf16 b1 = (bf16)f2bf(o1), b2 = (bf16)f2bf(o2);
#pragma unroll
              for (int h = 0; h < NHEAD; ++h) if (pr) { KB[kt_off(r, h, QKN + lane)] = b1; KB[kt_off(r, h, QKN + 16 + lane)] = b2; } }
            { const f32x4 p0 = up4(cur.ah0) * up4(cur.ac0); f32x4 p1 = (f32x4){0.f, 0.f, 0.f, 0.f}, p2 = p1;
              if (t >= 1) p1 = up4(cur.ah1) * up4(cur.ac1); else if (!pr) p1 = *(const f32x4*)(sta + ((size_t)n * 2 + 1) * BRW + c);
              if (t >= 2) p2 = up4(cur.ah2) * up4(cur.ac2); else if (!pr) p2 = *(const f32x4*)(sta + ((size_t)n * 2 + t) * BRW + c);
              const f32x4 cv = w0 * p2 + w1 * p1 + w2 * p0; st4bf(YS + (size_t)r * DM + c, up4(cur.ab) * cv);
              if (pr) { if (t >= SEQ - 2) *(f32x4*)(out + OFF_CAP + (((size_t)L * 2 + (r >> 13)) * 2 + (t - (SEQ - 2))) * BRW + c) = p0; }
              else if (t >= 2) *(f32x4*)(out + OFF_CAS + (((size_t)L * NSEQ_S + n) * 2 + (t - 2)) * BRW + c) = p0; }
            cur = nxt; nxt = nx2;
        }
#undef PREP_ROW
    }
    {
        const float* cfw = I.p(22) + (size_t)L * 31 * BRW; const float* cfb = I.p(23) + L * BRW; const float* lng = I.p(24) + L * BRW; const float* lnb = I.p(25) + L * BRW;
        LAS float* G = (LAS float*)(F.lds + RING_OFF); LAS float* Wl = (LAS float*)(F.lds + RING_OFF + 94 * 256 * 4);
        const int c = 4 * lane; const f32x4 cb4 = *(const f32x4*)(cfb + c), g4 = *(const f32x4*)(lng + c), b4 = *(const f32x4*)(lnb + c);
        for (int u = F.vcu; u < 256; u += F.G) {
            const int b = u >> 7, t0 = (u & 127) * 64; const size_t rb = (size_t)b * SEQ;
            __syncthreads();
            {
                v2u aw[12], gw2[12];
#pragma unroll
                for (int k = 0; k < 12; ++k) { int i = wave + k * NWAVES; i = i < 94 ? i : 93; int tau = t0 - 30 + i; tau = tau < 0 ? 0 : tau; const bf16* Zr = Z + (rb + tau) * INP; aw[k] = *(const v2u*)(Zr + ZC_DV + c); gw2[k] = *(const v2u*)(Zr + ZC_DG + c); }
                f32x4 wv[4];
#pragma unroll
                for (int k = 0; k < 4; ++k) { const int e = F.tid + k * NWAVES * 64; wv[k] = *(const f32x4*)(cfw + 4 * (e < 31 * 64 ? e : 31 * 64 - 1)); }
#pragma unroll
                for (int k = 0; k < 4; ++k) { const int e = F.tid + k * NWAVES * 64; if (e < 31 * 64) *(LAS f32x4*)(Wl + 4 * e) = wv[k]; }
#pragma unroll
                for (int k = 0; k < 12; ++k) { const int i = wave + k * NWAVES; const float keep = (t0 - 30 + i >= 0) ? 1.f : 0.f;
                    const f32x4 a = (f32x4){bflo(aw[k].x), bfhi(aw[k].x), bflo(aw[k].y), bfhi(aw[k].y)}, g = (f32x4){bflo(gw2[k].x), bfhi(gw2[k].x), bflo(gw2[k].y), bfhi(gw2[k].y)};
                    const f32x4 v = (f32x4){a[0] * sigm1(g[0]), a[1] * sigm1(g[1]), a[2] * sigm1(g[2]), a[3] * sigm1(g[3])} * keep;
                    if (i < 94) *(LAS f32x4*)(G + i * 256 + c) = v; } }
            __syncthreads();
            for (int k2 = 0; k2 < 4; ++k2) { const int ir = wave * 8 + 2 * k2; f32x4 a0 = cb4, a1 = cb4;
                f32x4 wprev = (f32x4){0.f, 0.f, 0.f, 0.f};
#pragma unroll 4
                for (int k = 0; k < 32; ++k) { const f32x4 gv = *(LAS f32x4*)(G + (ir + k) * 256 + c); f32x4 wk = wprev; if (k < 31) { wk = *(LAS f32x4*)(Wl + k * 256 + c); a0 += wk * gv; } if (k >= 1) a1 += wprev * gv; wprev = wk; }
#pragma unroll
                for (int h2 = 0; h2 < 2; ++h2) { const f32x4 a = h2 ? a1 : a0; const int irr = ir + h2, t = t0 + irr;
                    const float mean = wave_sum((a[0] + a[1]) + (a[2] + a[3])) * (1.0f / 256.0f); const f32x4 d = a - mean;
                    const float var = wave_sum((d[0] * d[0] + d[1] * d[1]) + (d[2] * d[2] + d[3] * d[3])) * (1.0f / 256.0f); const float rs = __builtin_amdgcn_rsqf(var + LN_EPS);
                    f32x4 y = d * rs * g4 + b4; y = (f32x4){silu1(y[0]), silu1(y[1]), silu1(y[2]), silu1(y[3])};
                    st4bf(YS + (rb + t) * DM + 768 + c, y);
                    if (t >= SEQ - 30) *(f32x4*)(out + OFF_CDP + (((size_t)L * 2 + b) * 30 + (t - (SEQ - 30))) * BRW + c) = *(LAS f32x4*)(G + (irr + 30) * 256 + c); } }
        }
        __syncthreads();
        const float* std_ = I.p(6) + (size_t)L * NSEQ_S * 30 * BRW;
        const bool deal2 = (F.G == 256); const int sd0 = deal2 ? ((F.vcu >= 64 && F.vcu < 128) ? (F.vcu - 64) * NWAVES + wave : NSR) : gw, sdstep = deal2 ? NSR : NGW;
        for (int rs_ = sd0; rs_ < NSR; rs_ += sdstep) { const int n = rs_ >> 2, t = rs_ & 3; const float* st = std_ + (size_t)n * 30 * BRW + c;
            f32x4 gl[4];
#pragma unroll
            for (int j = 0; j < 4; ++j) gl[j] = glu4(Z + (size_t)(NPR + 4 * n + j) * INP, c);
            f32x4 a = cb4;
#pragma unroll 8
            for (int k = 0; k < 31; ++k) { const int i = t + k; f32x4 v = *(const f32x4*)(st + (size_t)(i < 30 ? i : 29) * BRW); if (i >= 30) { const int j = i - 30; v = j == 0 ? gl[0] : j == 1 ? gl[1] : j == 2 ? gl[2] : gl[3]; }
                a += *(const f32x4*)(cfw + k * BRW + c) * v; }
            const float mean = wave_sum((a[0] + a[1]) + (a[2] + a[3])) * (1.0f / 256.0f); const f32x4 d = a - mean;
            const float var = wave_sum((d[0] * d[0] + d[1] * d[1]) + (d[2] * d[2] + d[3] * d[3])) * (1.0f / 256.0f); const float rs = __builtin_amdgcn_rsqf(var + LN_EPS);
            f32x4 y = d * rs * g4 + b4; y = (f32x4){silu1(y[0]), silu1(y[1]), silu1(y[2]), silu1(y[3])};
            st4bf(YS + (size_t)(NPR + rs_) * DM + 768 + c, y);
            { float* so = out + OFF_CDS + ((size_t)L * NSEQ_S + n) * 30 * BRW + c; f32x4 cp[7];
#pragma unroll
                for (int q = 0; q < 7; ++q) { const int j = t + 4 * q; cp[q] = *(const f32x4*)(st + (size_t)((j < 26 ? j : 25) + 4) * BRW); }
#pragma unroll
                for (int q = 0; q < 7; ++q) { const int j = t + 4 * q; if (j < 26) *(f32x4*)(so + (size_t)j * BRW) = cp[q]; }
                *(f32x4*)(so + (size_t)(26 + t) * BRW) = t == 0 ? gl[0] : t == 1 ? gl[1] : t == 2 ? gl[2] : gl[3]; }
        }
    }
    {
        const float* gmg = I.p(14) + L * BRW; const float* gbs = I.p(16) + L * 4 * 128; const float* gws = I.p(15) + (size_t)L * 4 * 128 * 128;
        const bf16* wsb = (const bf16*)(F.ws + WS_WSB) + (size_t)L * 4 * 128 * 128;
        LAS bf16* vT = (LAS bf16*)(F.lds + RING_OFF);
        const int c = 4 * lane; const f32x4 gg = *(const f32x4*)(gmg + c);
        const int fr = lane & 15, fq = lane >> 4;
        for (int u = F.vcu; u < 128; u += F.G) {
            const size_t r0 = (size_t)u * 128;
            __syncthreads();
            v2u xu[8][2]; float bsa[8]; const int gq = wave >> 1;
#pragma unroll
            for (int it = 0; it < 8; ++it) { const int i = 16 * it + fr; const bf16* Zr = Z + (r0 + i) * INP; bsa[it] = gbs[gq * 128 + i];
#pragma unroll
                for (int ci = 0; ci < 2; ++ci) xu[it][ci] = *(const v2u*)(Zr + ZC_BU + (2 * wave + ci) * 16 + 4 * fq); }
            { v2u xw[16];
#pragma unroll
                for (int k = 0; k < 16; ++k) xw[k] = *(const v2u*)(Z + (r0 + wave * 16 + k) * INP + ZC_BV + c);
#pragma unroll
                for (int k = 0; k < 16; ++k) { const int i = wave * 16 + k; const f32x4 x = (f32x4){bflo(xw[k].x), bfhi(xw[k].x), bflo(xw[k].y), bfhi(xw[k].y)};
                    const f32x4 ge = (f32x4){gelu_tanh(x[0]), gelu_tanh(x[1]), gelu_tanh(x[2]), gelu_tanh(x[3])};
                    const float ss = wave_sum((ge[0] * ge[0] + ge[1] * ge[1]) + (ge[2] * ge[2] + ge[3] * ge[3])); const float rs = __builtin_amdgcn_rsqf(ss * (1.0f / 256.0f) + RMS_EPS);
                    const f32x4 v = ge * rs * gg;
#pragma unroll
                    for (int e = 0; e < 4; ++e) vT[(c + e) * 136 + i] = (bf16)f2bf(v[e]); } }
            __syncthreads();
            const int g = wave >> 1; bf16x8 af[2][4];
#pragma unroll
            for (int ci = 0; ci < 2; ++ci)
#pragma unroll
                for (int ks = 0; ks < 4; ++ks) af[ci][ks] = *(LAS bf16x8*)(vT + ((2 * wave + ci) * 16 + fr) * 136 + 32 * ks + 8 * fq);
            bf16x8 bq[2][4];
#pragma unroll
            for (int ks = 0; ks < 4; ++ks) if (32 * ks <= 15) bq[0][ks] = *(const bf16x8*)(wsb + ((size_t)g * 128 + fr) * 128 + 32 * ks + 8 * fq);
#pragma unroll
            for (int it = 0; it < 8; ++it) { f32x4 acc0 = (f32x4){0.f, 0.f, 0.f, 0.f}, acc1 = acc0;
                if (it + 1 < 8) {
#pragma unroll
                    for (int ks = 0; ks < 4; ++ks) if (32 * ks <= 16 * (it + 1) + 15) bq[(it + 1) & 1][ks] = *(const bf16x8*)(wsb + ((size_t)g * 128 + 16 * (it + 1) + fr) * 128 + 32 * ks + 8 * fq); }
#pragma unroll
                for (int ks = 0; ks < 4; ++ks) if (32 * ks <= 16 * it + 15) { const bf16x8 bfr = bq[it & 1][ks];
                    acc0 = __builtin_amdgcn_mfma_f32_16x16x32_bf16(af[0][ks], bfr, acc0, 0, 0, 0); acc1 = __builtin_amdgcn_mfma_f32_16x16x32_bf16(af[1][ks], bfr, acc1, 0, 0, 0); }
                const int i = 16 * it + fr; const float bsv = bsa[it];
#pragma unroll
                for (int ci = 0; ci < 2; ++ci) { const int c4 = (2 * wave + ci) * 16 + 4 * fq; const v2u xr = xu[it][ci]; const f32x4 x = (f32x4){bflo(xr.x), bfhi(xr.x), bflo(xr.y), bfhi(xr.y)}; const f32x4 a = ci ? acc1 : acc0;
                    const f32x4 y = (f32x4){gelu_tanh(x[0]) * (a[0] + bsv), gelu_tanh(x[1]) * (a[1] + bsv), gelu_tanh(x[2]) * (a[2] + bsv), gelu_tanh(x[3]) * (a[3] + bsv)};
                    st4bf(YS + (r0 + i) * DM + 256 + c4, y); } }
        }
        __syncthreads();
        { const int g = lane >> 4;
          const bool deal2 = (F.G == 256); const int sb0 = deal2 ? ((F.vcu >= 64 && F.vcu < 80) ? (F.vcu - 64) * NWAVES + wave : NSEQ_S) : gw, sbstep = deal2 ? NSEQ_S : NGW;
          for (int n = sb0; n < NSEQ_S; n += sbstep) { f32x4 v[4];
#pragma unroll
            for (int j = 0; j < 4; ++j) { const f32x4 x = ld4bf(Z + (size_t)(NPR + 4 * n + j) * INP + ZC_BV + c);
                const f32x4 ge = (f32x4){gelu_tanh(x[0]), gelu_tanh(x[1]), gelu_tanh(x[2]), gelu_tanh(x[3])};
                const float ss = wave_sum((ge[0] * ge[0] + ge[1] * ge[1]) + (ge[2] * ge[2] + ge[3] * ge[3])); const float rs = __builtin_amdgcn_rsqf(ss * (1.0f / 256.0f) + RMS_EPS);
                v[j] = ge * rs * gg; *(f32x4*)(out + OFF_VS + (((size_t)L * NSEQ_S + n) * 4 + j) * BRW + c) = v[j]; }
#pragma unroll
            for (int i = 0; i < 4; ++i) { f32x4 o = (f32x4){0.f, 0.f, 0.f, 0.f};
#pragma unroll
                for (int j = 0; j <= i; ++j) o += v[j] * gws[((size_t)g * 128 + i) * 128 + j];
                o += gbs[g * 128 + i]; const f32x4 x = ld4bf(Z + (size_t)(NPR + 4 * n + i) * INP + ZC_BU + c);
                st4bf(YS + (size_t)(NPR + 4 * n + i) * DM + 256 + c, (f32x4){gelu_tanh(x[0]) * o[0], gelu_tanh(x[1]) * o[1], gelu_tanh(x[2]) * o[2], gelu_tanh(x[3]) * o[3]}); }
          } }
    }
}

__device__ __forceinline__ void p_final(Frame& F, const InPtrs& I) {
    const int gw = F.vcu * NWAVES + F.wave, NGW = F.G * NWAVES, lane = F.lane; const float* ssq = (const float*)(F.ws + WS_SSQ) + 6 * SSQ_STRIDE; const float* fg = I.p(32);
    const bf16* hb = (const bf16*)(F.ws + WS_HB);
    f32x4 g[4];
#pragma unroll
    for (int j = 0; j < 4; ++j) g[j] = *(const f32x4*)(fg + 4 * lane + 256 * j);
    v2u cur[4], nxt[4]; float sc = 0.f, sn = 0.f;
    if (gw < MROWS) { sc = lane < 16 ? ssq[(size_t)gw * 16 + lane] : 0.f;
#pragma unroll
        for (int j = 0; j < 4; ++j) cur[j] = *(const v2u*)(hb + (size_t)gw * DM + 4 * lane + 256 * j); }
    for (int m = gw; m < MROWS; m += NGW) { const int m2 = m + NGW;
        if (m2 < MROWS) { sn = lane < 16 ? ssq[(size_t)m2 * 16 + lane] : 0.f;
#pragma unroll
            for (int j = 0; j < 4; ++j) nxt[j] = *(const v2u*)(hb + (size_t)m2 * DM + 4 * lane + 256 * j); }
        const float rs = __builtin_amdgcn_rsqf(wave_sum(sc) * (1.0f / DM) + RMS_EPS); GAS f32x4* p = (GAS f32x4*)(F.out + (size_t)m * DM) + lane;
#pragma unroll
        for (int j = 0; j < 4; ++j) p[64 * j] = (f32x4){bflo(cur[j].x), bfhi(cur[j].x), bflo(cur[j].y), bfhi(cur[j].y)} * rs * g[j];
        sc = sn;
#pragma unroll
        for (int j = 0; j < 4; ++j) cur[j] = nxt[j]; }
}

template <bool GATED, class Epi>
__device__ __forceinline__ void mini_gemm(LAS unsigned char* lds, const bf16* A, int lda, const bf16* Bt, int ldb, int K, size_t a_sub, size_t b_sub, const bf16* Zg, const Epi& epi, int vcu, int G) {
    int tid_ = threadIdx.x; asm volatile("" : "+v"(tid_));
    const int tid = tid_, lane = tid & 63, fr = lane & 15, fq = lane >> 4; const int wid = __builtin_amdgcn_readfirstlane(tid >> 6);
#define MINI_RED(w) ((LAS float*)(lds + ((w) < 4 ? 32768 + (w) * 8192 : 98304 + ((w) - 4) * 8192)))
    LAS float* red = MINI_RED(wid);
    const int nks = K >> 5;
    for (int item = vcu; item < 256; item += G) {
        const int rb = item >> 4, cb = item & 15;
        pg8::f32x4 acc[2][4];
#pragma unroll
        for (int rt = 0; rt < 2; ++rt)
#pragma unroll
            for (int ct = 0; ct < 4; ++ct) acc[rt][ct] = (pg8::f32x4){0.f, 0.f, 0.f, 0.f};
#pragma unroll 2
        for (int sub = 0; sub < (GATED ? 4 : 1); ++sub) {
            pg8::f32x4 pa[2][4];
#pragma unroll
            for (int rt = 0; rt < 2; ++rt)
#pragma unroll
                for (int ct = 0; ct < 4; ++ct) pa[rt][ct] = GATED ? (pg8::f32x4){0.f, 0.f, 0.f, 0.f} : acc[rt][ct];
            const bf16* Ap = A + (size_t)(rb * 32 + fr) * lda + sub * a_sub + 8 * fq;
            const bf16* Bp = Bt + sub * b_sub + (size_t)(cb * 64 + fr) * ldb + 8 * fq;
            v2u gwv[2][4];
            if (GATED) {
#pragma unroll
                for (int rt = 0; rt < 2; ++rt)
#pragma unroll
                    for (int ct = 0; ct < 4; ++ct) gwv[rt][ct] = *(const v2u*)(Zg + (size_t)(NPR + rb * 32 + 16 * rt + fr) * INP + ZC_GATE + sub * DM + cb * 64 + 16 * ct + 4 * fq); }
#pragma unroll 4
            for (int ks = wid; ks < nks; ks += NWAVES) {
                const bf16x8 a0 = *(const bf16x8*)(Ap + 32 * ks), a1 = *(const bf16x8*)(Ap + (size_t)16 * lda + 32 * ks);
                bf16x8 b[4];
#pragma unroll
                for (int ct = 0; ct < 4; ++ct) b[ct] = *(const bf16x8*)(Bp + (size_t)16 * ct * ldb + 32 * ks);
#pragma unroll
                for (int ct = 0; ct < 4; ++ct) { pa[0][ct] = __builtin_amdgcn_mfma_f32_16x16x32_bf16(b[ct], a0, pa[0][ct], 0, 0, 0); pa[1][ct] = __builtin_amdgcn_mfma_f32_16x16x32_bf16(b[ct], a1, pa[1][ct], 0, 0, 0); }
            }
            if (GATED) {
#pragma unroll
                for (int rt = 0; rt < 2; ++rt)
#pragma unroll
                    for (int ct = 0; ct < 4; ++ct) { const v2u gw = gwv[rt][ct];
                        acc[rt][ct] += pa[rt][ct] * (pg8::f32x4){bflo(gw.x), bfhi(gw.x), bflo(gw.y), bfhi(gw.y)}; }
            } else {
#pragma unroll
                for (int rt = 0; rt < 2; ++rt)
#pragma unroll
                    for (int ct = 0; ct < 4; ++ct) acc[rt][ct] = pa[rt][ct];
            }
        }
#pragma unroll
        for (int rt = 0; rt < 2; ++rt)
#pragma unroll
            for (int ct = 0; ct < 4; ++ct) *(LAS pg8::f32x4*)(red + ((16 * rt + fr) * 64 + 16 * ct + 4 * fq)) = acc[rt][ct];
        __syncthreads();
        { const int r = tid >> 4, c4 = (tid & 15) * 4; pg8::f32x4 v = *(LAS pg8::f32x4*)(MINI_RED(0) + (r * 64 + c4));
#pragma unroll
          for (int w = 1; w < NWAVES; ++w) v += *(LAS pg8::f32x4*)(MINI_RED(w) + (r * 64 + c4));
          epi(NPR + rb * 32 + r, cb * 64 + c4, v, lane); }
        __syncthreads();
    }
#undef MINI_RED
}
struct MiniRes { bf16* hb; float* ssq_out; float scale;
    __device__ __forceinline__ void operator()(int row, int col, pg8::f32x4 v, int lane) const {
        bf16* hp = hb + (size_t)row * DM + col; const pg8::f32x4 o = ld4bf(hp) + v * scale; st4bf(hp, o);
        float sq = (o[0] * o[0] + o[1] * o[1]) + (o[2] * o[2] + o[3] * o[3]);
        sq = xadd8(xadd4(xadd2(xadd1(sq))));
        if ((lane & 15) == 0) ssq_out[(size_t)row * 16 + (col >> 6)] = sq; } };
struct MiniBranch { bf16* mg;
    __device__ __forceinline__ void operator()(int row, int col, pg8::f32x4 v, int) const { st4bf(mg + (size_t)row * DM + col, v); } };
struct MiniMla { bf16* Qb; bf16* Kb; bf16* Vb; const float* rope;
    __device__ __forceinline__ void operator()(int row, int col, pg8::f32x4 v, int lane) const {
        pg8::f32x4 pv; pv[0] = __shfl_xor(v[0], 4); pv[1] = __shfl_xor(v[1], 4); pv[2] = __shfl_xor(v[2], 4); pv[3] = __shfl_xor(v[3], 4);
        if (col < 384) { const int g32 = col >> 5;
            if (g32 % 3 == 2) { const int pos = SEQ + (row & 3); const int i0 = col & 15; const bool second = (col & 16) != 0;
                const pg8::f32x4 cs = *(const pg8::f32x4*)(rope + (size_t)pos * 32 + i0), sn = *(const pg8::f32x4*)(rope + (size_t)pos * 32 + 16 + i0);
                v = second ? (v * cs + pv * sn) : (v * cs - pv * sn); }
            st4bf(Qb + (size_t)row * 384 + col, v * ATT_C2); }
    } };

namespace att {
using f32x16 = __attribute__((ext_vector_type(16))) float;
using s16x4 = __attribute__((ext_vector_type(4))) short;
typedef short v4i16_t __attribute__((ext_vector_type(4)));
typedef LAS const char* lds_cptr;
constexpr int KT_BYTES = 12288, VT_BYTES = 8192, SLOT = 2 * KT_BYTES + 2 * VT_BYTES  , NSLOT = 3, LDS_WSF = NSLOT * SLOT  , LDS_END = LDS_WSF + 8 * 256;
static_assert(LDS_END <= RING_BYTES, "attention LDS");
__device__ __forceinline__ int crow(int r, int hi) { return (r & 3) + 8 * (r >> 2) + 4 * hi; }
__device__ __forceinline__ void glds16(const void* gsrc, unsigned lds_dst) { unsigned keep;
    asm volatile("s_mov_b32 %0, m0\n\ts_mov_b32 m0, %2\n\ts_nop 0\n\tglobal_load_lds_dwordx4 %1, off\n\ts_mov_b32 m0, %0" : "=&s"(keep) : "v"(gsrc), "s"(lds_dst) : "memory"); }
__device__ __forceinline__ void glds16s(const void* sbase, unsigned voff, unsigned lds_dst) { unsigned keep;
    asm volatile("s_mov_b32 %0, m0\n\ts_mov_b32 m0, %3\n\ts_nop 0\n\tglobal_load_lds_dwordx4 %1, %2\n\ts_mov_b32 m0, %0" : "=&s"(keep) : "v"(voff), "s"(sbase), "s"(lds_dst) : "memory"); }
typedef float f32x2_t __attribute__((ext_vector_type(2))); typedef __bf16 bf16x2_t __attribute__((ext_vector_type(2)));
__device__ __forceinline__ unsigned cvtpk(float lo, float hi) { f32x2_t v = {lo, hi}; bf16x2_t b = __builtin_convertvector(v, bf16x2_t); return __builtin_bit_cast(unsigned, b); }
#define ATT_WAIT_BAR(N) asm volatile("s_waitcnt vmcnt(" #N ") lgkmcnt(0)\n\ts_barrier" ::: "memory")
__device__ __forceinline__ s16x4 vtr(lds_cptr p) { return __builtin_bit_cast(s16x4, __builtin_amdgcn_ds_read_tr16_b64_v4i16((LAS v4i16_t*)p)); }

constexpr float FL_THR = 8.0f;
template <bool MASK, bool SPEC>
__device__ __forceinline__ void flash_softmax_half(const int hsel, f32x16 p, f32x16 (&o)[2], float& m, float& l, v4u (&pw)[4], int kbase, int qrel, int r32, int hi) {
    if (MASK) { asm volatile("" : "+v"(qrel));
#pragma unroll
        for (int r = 0; r < 16; ++r) { const int kv = kbase + 32 * hsel + crow(r, hi); if (kv > qrel) p[r] = -INFINITY; } }
    float rm = __builtin_fmaxf(p[0], p[1]);
#pragma unroll
    for (int r = 2; r < 16; ++r) rm = __builtin_fmaxf(rm, p[r]);
    rm = xmax32(rm);
    float sacc = 0.f; f32x2 sacc2 = (f32x2){0.f, 0.f};
    if (SPEC) {
#pragma unroll
        for (int r = 0; r < 16; r += 2) { f32x2 x = (f32x2){p[r], p[r + 1]} - (f32x2){m, m}; x = (f32x2){__builtin_amdgcn_exp2f(x[0]), __builtin_amdgcn_exp2f(x[1])}; p[r] = x[0]; p[r + 1] = x[1]; sacc2 += x; }
        pw[2 * hsel] = (v4u){cvtpk(p[0], p[1]), cvtpk(p[2], p[3]), cvtpk(p[4], p[5]), cvtpk(p[6], p[7])};
        pw[2 * hsel + 1] = (v4u){cvtpk(p[8], p[9]), cvtpk(p[10], p[11]), cvtpk(p[12], p[13]), cvtpk(p[14], p[15])}; }
    if (__any(rm > m + FL_THR)) {
        const float mnew = __builtin_fmaxf(m, rm); const float f = __builtin_amdgcn_exp2f(m - mnew); l *= f; m = mnew;
#pragma unroll
        for (int r = 0; r < 16; ++r) { const int src = (r & 3) + 8 * (r >> 2);
            const float fa = __builtin_bit_cast(float, __builtin_amdgcn_readlane(__builtin_bit_cast(int, f), src)), fb = __builtin_bit_cast(float, __builtin_amdgcn_readlane(__builtin_bit_cast(int, f), src + 4));
            const float fr_ = hi ? fb : fa; o[0][r] *= fr_; o[1][r] *= fr_; }
#pragma unroll
        for (int k = 0; k < 4; ++k) if (k < 2 * hsel + (SPEC ? 2 : 0)) {
#pragma unroll
            for (int e = 0; e < 4; ++e) { const unsigned w = pw[k][e]; pw[k][e] = cvtpk(bflo(w) * f, bfhi(w) * f); } }
        if (SPEC) sacc2 = sacc2 * f; }
    if (!SPEC) {
#pragma unroll
        for (int r = 0; r < 16; r += 2) { f32x2 x = (f32x2){p[r], p[r + 1]} - (f32x2){m, m}; x = (f32x2){__builtin_amdgcn_exp2f(x[0]), __builtin_amdgcn_exp2f(x[1])}; p[r] = x[0]; p[r + 1] = x[1]; sacc2 += x; }
        pw[2 * hsel] = (v4u){cvtpk(p[0], p[1]), cvtpk(p[2], p[3]), cvtpk(p[4], p[5]), cvtpk(p[6], p[7])};
        pw[2 * hsel + 1] = (v4u){cvtpk(p[8], p[9]), cvtpk(p[10], p[11]), cvtpk(p[12], p[13]), cvtpk(p[14], p[15])}; }
    l += sacc + (sacc2[0] + sacc2[1]);
}
template <bool PV, bool QK, bool MASK, bool SPEC>
__device__ __forceinline__ void flash_step(f32x16 (&o)[2], float& m, float& l, v4u (&pw)[4], lds_cptr Kt, lds_cptr Vt, lds_cptr Qt0, int kbase, int wq, int lane) {
    asm volatile("" : "+v"(lane));
    const int r32 = lane & 31, hi = lane >> 5, qrel = wq * 32 + r32; const lds_cptr Qt = Qt0 + (wq * 32 + r32) * QT_STRIDE + hi * 16;
    bf16x8 qr[6];
    if (QK) {
#pragma unroll
        for (int d0 = 0; d0 < 6; ++d0) qr[d0] = *(LAS const bf16x8*)(Qt + d0 * 32); }
    lds_cptr kb = Kt + hi * 1024 + r32 * 16;
    lds_cptr vp = Vt + ((r32 >> 4) & 1) * 32 + (r32 & 3) * 8 + (4 * hi + ((r32 & 15) >> 2)) * 64;
    f32x16 pc0 = f32x16{}, pc1 = f32x16{};
    { bf16x8 kfa[6];
      if (QK) {
#pragma unroll
        for (int d0 = 0; d0 < 6; ++d0) kfa[d0] = *(LAS const bf16x8*)(kb + d0 * 2048); }
      __builtin_amdgcn_sched_barrier(0x0407);
      if (QK) {
#pragma unroll
        for (int d0 = 0; d0 < 6; ++d0) pc0 = __builtin_amdgcn_mfma_f32_32x32x16_bf16(kfa[d0], qr[d0], pc0, 0, 0, 0); } }
    { s16x4 vlo[4], vhi[4];
      if (PV) {
#pragma unroll
        for (int ks = 0; ks < 2; ++ks)
#pragma unroll
            for (int d0 = 0; d0 < 2; ++d0) { vlo[ks * 2 + d0] = vtr(vp + d0 * 4096 + ks * 1024); vhi[ks * 2 + d0] = vtr(vp + d0 * 4096 + ks * 1024 + 512); } }
      __builtin_amdgcn_sched_barrier(0x0407);
      if (PV) {
#pragma unroll
        for (int ks = 0; ks < 2; ++ks)
#pragma unroll
            for (int d0 = 0; d0 < 2; ++d0) { const int i = ks * 2 + d0;
                const bf16x8 vf = (bf16x8){vlo[i][0], vlo[i][1], vlo[i][2], vlo[i][3], vhi[i][0], vhi[i][1], vhi[i][2], vhi[i][3]};
                o[d0] = __builtin_amdgcn_mfma_f32_32x32x16_bf16(__builtin_bit_cast(bf16x8, pw[ks]), vf, o[d0], 0, 0, 0); } } }
    { bf16x8 kfb[6];
      if (QK) {
#pragma unroll
        for (int d0 = 0; d0 < 6; ++d0) kfb[d0] = *(LAS const bf16x8*)(kb + d0 * 2048 + 512); }
      __builtin_amdgcn_sched_barrier(0x0407);
      if (QK) {
#pragma unroll
        for (int d0 = 0; d0 < 6; ++d0) pc1 = __builtin_amdgcn_mfma_f32_32x32x16_bf16(kfb[d0], qr[d0], pc1, 0, 0, 0); } }
    { s16x4 vlo[4], vhi[4];
      if (PV) {
#pragma unroll
        for (int ks = 0; ks < 2; ++ks)
#pragma unroll
            for (int d0 = 0; d0 < 2; ++d0) { vlo[ks * 2 + d0] = vtr(vp + d0 * 4096 + (2 + ks) * 1024); vhi[ks * 2 + d0] = vtr(vp + d0 * 4096 + (2 + ks) * 1024 + 512); } }
      __builtin_amdgcn_sched_barrier(0x0407);
      if (PV) {
#pragma unroll
        for (int ks = 0; ks < 2; ++ks)
#pragma unroll
            for (int d0 = 0; d0 < 2; ++d0) { const int i = ks * 2 + d0;
                const bf16x8 vf = (bf16x8){vlo[i][0], vlo[i][1], vlo[i][2], vlo[i][3], vhi[i][0], vhi[i][1], vhi[i][2], vhi[i][3]};
                o[d0] = __builtin_amdgcn_mfma_f32_32x32x16_bf16(__builtin_bit_cast(bf16x8, pw[2 + ks]), vf, o[d0], 0, 0, 0); } }
      __builtin_amdgcn_sched_barrier(0x0407); }
    if (QK) { flash_softmax_half<MASK, SPEC>(0, pc0, o, m, l, pw, kbase, qrel, r32, hi);
              flash_softmax_half<MASK, false>(1, pc1, o, m, l, pw, kbase, qrel, r32, hi); }
}

__device__ __forceinline__ void flash_unit(int b, int h, int qb, const bf16* Qb, const bf16* Kb, const bf16* Vb, bf16* YS, LAS unsigned char* lds) {
    int tid_ = threadIdx.x; asm volatile("" : "+v"(tid_));
    const int tid = tid_, lane = tid & 63, r32 = lane & 31, hi = lane >> 5; const int wid = __builtin_amdgcn_readfirstlane(tid >> 6);
    const int g = wid >> 2, wq = wid & 3;
    const size_t rowbase = (size_t)b * SEQ; const int q0 = qb * 128; const int n = qb + 1;
    const unsigned lds0 = (unsigned)(uintptr_t)lds;
    LAS float* wsf = (LAS float*)(lds + LDS_WSF) + wid * 64;
    { const bf16* Qg = Qb + (rowbase + q0) * 384 + h * QKD;
#pragma unroll
      for (int i = 0; i < 3; ++i) { const int ch = tid + 512 * i, row = ch / 12, c = ch - row * 12;
          const v4u v = *(const v4u*)(Qg + (size_t)row * 384 + c * 8); *(LAS v4u*)(lds + QTILE_OFF + row * QT_STRIDE + c * 16) = v; } }
    const lds_cptr Qt0 = (lds_cptr)lds + QTILE_OFF;
    constexpr int KSL = 2 * KT_BYTES, VSL = 2 * VT_BYTES, KRING = 3 * KSL;
    const bf16* Kl = Kb + (size_t)(b * 4 + h) * SEQ * 96; const bf16* Vl = Vb + (size_t)(b * 4 + h) * SEQ * 64; const unsigned lo16 = (unsigned)lane * 16u;
    const int c1 = wid < 4 ? 8 + wid : wid - 4; const int t1 = wid < 4 ? 0 : 1;
    const int ko0 = wid * 512, ko1 = t1 * 6144 + c1 * 512, ko2 = 6144 + (wid + 4) * 512, vo0 = wid * 512, vo1 = 4096 + wid * 512;
    const unsigned kd0 = lds0 + wid * 1024, kd1 = lds0 + t1 * KT_BYTES + c1 * 1024, kd2 = lds0 + KT_BYTES + (wid + 4) * 1024;
    const unsigned vd0 = lds0 + KRING + wid * 1024, vd1 = vd0 + VT_BYTES;
#if defined(FPROBE) && (FPROBE & 8)
#define GLDS2(a, b) do { glds16s(a, lo16, b); glds16s(a, lo16, b); } while (0)
#define WB5() ATT_WAIT_BAR(10)
#define WB2() ATT_WAIT_BAR(4)
#else
#define GLDS2(a, b) glds16s(a, lo16, b)
#define WB5() ATT_WAIT_BAR(5)
#define WB2() ATT_WAIT_BAR(2)
#endif
#define ATT_KDMA(t, slot) do { const int ko_ = (t) * 2 * 6144; const unsigned so_ = (unsigned)(slot) * KSL; \
        GLDS2(Kl + (ko_ + ko0), (unsigned)__builtin_amdgcn_readfirstlane(kd0 + so_)); GLDS2(Kl + (ko_ + ko1), (unsigned)__builtin_amdgcn_readfirstlane(kd1 + so_)); \
        GLDS2(Kl + (ko_ + ko2), (unsigned)__builtin_amdgcn_readfirstlane(kd2 + so_)); } while (0)
#define ATT_VDMA(t, slot) do { const int vo_ = (t) * 2 * 4096; const unsigned so_ = (unsigned)(slot) * VSL; \
        GLDS2(Vl + (vo_ + vo0), (unsigned)__builtin_amdgcn_readfirstlane(vd0 + so_)); GLDS2(Vl + (vo_ + vo1), (unsigned)__builtin_amdgcn_readfirstlane(vd1 + so_)); } while (0)
#define ATT_KP(slot) ((lds_cptr)lds + (slot) * KSL + g * KT_BYTES)
#define ATT_VP(slot) ((lds_cptr)lds + KRING + (slot) * VSL + g * VT_BYTES)
    ATT_KDMA(0, 0); if (n > 1) ATT_KDMA(1, 1); ATT_VDMA(0, 0);
    float m = -1e30f, l = 0.f; f32x16 o[2]; o[0] = f32x16{}; o[1] = f32x16{}; v4u pw[4];
#pragma unroll
    for (int k = 0; k < 4; ++k) pw[k] = (v4u){0u, 0u, 0u, 0u};
    if (n > 1) WB5(); else WB2();
    if (n > 2) ATT_KDMA(2, 2); if (n > 1) ATT_VDMA(1, 1);
    if (n == 1) flash_step<false, true, true, false>(o, m, l, pw, ATT_KP(0), ATT_VP(0), Qt0, 64 * g, wq, lane);
    else flash_step<false, true, false, false>(o, m, l, pw, ATT_KP(0), ATT_VP(0), Qt0, 64 * g, wq, lane);
    { int ks = 1, vs = 0, ks2 = 0, vs1 = 2;
      for (int i = 1; i < n; ++i) {
        if (i + 1 < n) WB5(); else WB2();
        if (i + 2 < n) ATT_KDMA(i + 2, ks2); if (i + 1 < n) ATT_VDMA(i + 1, vs1);
        if (i == n - 1) flash_step<true, true, true, false>(o, m, l, pw, ATT_KP(ks), ATT_VP(vs), Qt0, 64 * g, wq, lane);
        else flash_step<true, true, false, true>(o, m, l, pw, ATT_KP(ks), ATT_VP(vs), Qt0, 64 * g, wq, lane);
        ks = ks == 2 ? 0 : ks + 1; vs = vs == 2 ? 0 : vs + 1; ks2 = ks2 == 2 ? 0 : ks2 + 1; vs1 = vs1 == 2 ? 0 : vs1 + 1;
      } }
    ATT_WAIT_BAR(0);
    flash_step<true, false, false, false>(o, m, l, pw, ATT_KP(0), ATT_VP((n - 1) % 3), Qt0, 64 * g, wq, lane);
#undef ATT_KDMA
#undef GLDS2
#undef WB5
#undef WB2
#undef ATT_VDMA
#undef ATT_KP
#undef ATT_VP
    ATT_WAIT_BAR(0);
    int lane2 = lane; asm volatile("" : "+v"(lane2));
    LAS float* mb = (LAS float*)(lds + KSL) + (wq * 64 + lane2) * 34;
    if (g == 1) {
#pragma unroll
        for (int r = 0; r < 16; ++r) { mb[r] = o[0][r]; mb[16 + r] = o[1][r]; }
        mb[32] = m; mb[33] = l; }
    ATT_WAIT_BAR(0);
    if (g == 0) {
        const float m1 = mb[32], l1 = mb[33]; const float mm = __builtin_fmaxf(m, m1); const float f0 = __builtin_amdgcn_exp2f(m - mm), f1 = __builtin_amdgcn_exp2f(m1 - mm);
        float lt = xadd32(l * f0 + l1 * f1); const float inv = 1.0f / lt;
        if (hi == 0) { wsf[r32] = f0 * inv; wsf[32 + r32] = f1 * inv; }
        asm volatile("s_waitcnt lgkmcnt(0)" ::: "memory");
        LAS bf16* stg = (LAS bf16*)(lds) + wq * 2048;
#pragma unroll
        for (int r = 0; r < 16; ++r) { const int orow = crow(r, hi); const float a0 = wsf[orow], a1 = wsf[32 + orow];
            stg[orow * 64 + r32] = (bf16)f2bf(o[0][r] * a0 + mb[r] * a1); stg[orow * 64 + 32 + r32] = (bf16)f2bf(o[1][r] * a0 + mb[16 + r] * a1); }
        asm volatile("s_waitcnt lgkmcnt(0)" ::: "memory");
        bf16* Ow = YS + (rowbase + q0 + wq * 32) * DM + 512 + h * VHD;
#pragma unroll
        for (int i = 0; i < 4; ++i) { const int row = i * 8 + (lane2 >> 3), ch = lane2 & 7; const v4u v = *(LAS const v4u*)(stg + row * 64 + ch * 8); *(v4u*)(Ow + (size_t)row * DM + ch * 8) = v; }
    }
    ATT_WAIT_BAR(0);
}

constexpr int DK_STRIDE = 336  , DK_TILE = 32 * DK_STRIDE  , DEC_QS = 8 * DK_TILE  , DEC_QS_STRIDE = 336, DEC_ML = DEC_QS + 16 * DEC_QS_STRIDE  ,
              DEC_OL = DEC_ML + 2 * 8 * 16 * 4  , DEC_END = DEC_OL + 16 * 128 * 4;
static_assert(DEC_END <= RING_BYTES && 8 * 128 * 16 * 4 <= DEC_QS, "decode LDS");
__device__ __forceinline__ void decode_seq(int n, int L, const InPtrs& I, const bf16* Qb, const float* outp, bf16* YS, LAS unsigned char* lds) {
    int tid_ = threadIdx.x; asm volatile("" : "+v"(tid_));
    const int tid = tid_, lane = tid & 63, fr = lane & 15, fq = lane >> 4; const int wid = __builtin_amdgcn_readfirstlane(tid >> 6);
    const float* wuk = I.p(20) + (size_t)L * KVR * 256; const float* wuv = I.p(21) + (size_t)L * KVR * 256;
    const float* clat = I.p(2) + (size_t)L * NPOOL * PAGE * KVR; const float* ckr = I.p(3) + (size_t)L * NPOOL * PAGE * QKR; const int* ptab = (const int*)I.p(4) + n * NPAGES;
    const float* nlat = outp + OFF_LATS + ((size_t)L * NSR + 4 * n) * KVR; const float* nkr = outp + OFF_KRS + ((size_t)L * NSR + 4 * n) * QKR;
    LAS unsigned char* Qs = lds + DEC_QS;
    f32x4 xl[16], xk[4];
#if defined(DEC_PLAIN)
#define DEC_LD(p) (*(p))
#else
#define DEC_LD(p) __builtin_nontemporal_load(p)
#endif
    int pid_cur = ptab[wid], pid_nxt = ptab[wid + NWAVES];
#define DEC_LOAD(jt) do { const int pid_ = pid_cur; const int k0_ = ((jt) & 3) * 32; \
        const float* lp_ = clat + (size_t)pid_ * PAGE * KVR + (size_t)(k0_ + (lane >> 5)) * KVR + (lane & 31) * 4; const float* kp_ = ckr + (size_t)pid_ * PAGE * QKR + (size_t)(k0_ + (lane >> 3)) * QKR + (lane & 7) * 4; \
        _Pragma("unroll") for (int i = 0; i < 16; ++i) xl[i] = DEC_LD((const f32x4*)(lp_ + (size_t)(2 * i) * KVR)); \
        _Pragma("unroll") for (int i = 0; i < 4; ++i) xk[i] = DEC_LD((const f32x4*)(kp_ + (size_t)(8 * i) * QKR)); } while (0)
    DEC_LOAD(0);
    __syncthreads();
    { const int j = tid >> 5, t = j >> 2, h = j & 3, cg = (tid & 31) * 4; const bf16* q = Qb + (size_t)(NPR + 4 * n + t) * 384 + h * QKD;
      float a[4] = {0.f, 0.f, 0.f, 0.f};
#pragma unroll 4
      for (int d = 0; d < QKN; d += 4) { const f32x4 qv = ld4bf(q + d);
#pragma unroll
          for (int e = 0; e < 4; ++e) { const f32x4 w = *(const f32x4*)(wuk + (size_t)(cg + e) * 256 + h * QKN + d); a[e] += (qv[0] * w[0] + qv[1] * w[1]) + (qv[2] * w[2] + qv[3] * w[3]); } }
      v2u pk; pk.x = pk2(a[0], a[1]); pk.y = pk2(a[2], a[3]); *(LAS v2u*)(Qs + j * DEC_QS_STRIDE + cg * 2) = pk;
      if ((tid & 31) < 8) *(LAS v2u*)(Qs + j * DEC_QS_STRIDE + 256 + (tid & 31) * 8) = *(const v2u*)(q + QKN + (tid & 31) * 4); }
    __syncthreads();
    bf16x8 qf[5];
#pragma unroll
    for (int ks = 0; ks < 5; ++ks) qf[ks] = *(LAS const bf16x8*)(Qs + fr * DEC_QS_STRIDE + (32 * ks + 8 * fq) * 2);
    LAS unsigned char* Kt = lds + wid * DK_TILE;
    float m = -1e30f, l = 0.f; f32x4 o[8];
#pragma unroll
    for (int ct = 0; ct < 8; ++ct) o[ct] = (f32x4){0.f, 0.f, 0.f, 0.f};
#pragma unroll 1
    for (int jt = 0; jt < 32; ++jt) { {
#pragma unroll
            for (int i = 0; i < 16; ++i) { v2u w; w.x = cvtpk(xl[i][0], xl[i][1]); w.y = cvtpk(xl[i][2], xl[i][3]); *(LAS v2u*)(Kt + (2 * i + (lane >> 5)) * DK_STRIDE + (lane & 31) * 8) = w; }
#pragma unroll
            for (int i = 0; i < 4; ++i) { v2u w; w.x = cvtpk(xk[i][0], xk[i][1]); w.y = cvtpk(xk[i][2], xk[i][3]); *(LAS v2u*)(Kt + (8 * i + (lane >> 3)) * DK_STRIDE + 256 + (lane & 7) * 8) = w; }
            if (jt + 1 < 32) { if (((jt + 1) & 3) == 0) { pid_cur = pid_nxt; if (jt + 5 < 32) pid_nxt = ptab[wid + NWAVES * ((jt + 5) >> 2)]; } DEC_LOAD(jt + 1); }
            asm volatile("s_waitcnt lgkmcnt(0)" ::: "memory");
            f32x4 s0 = (f32x4){0.f, 0.f, 0.f, 0.f}, s1 = s0;
#pragma unroll
            for (int ks = 0; ks < 5; ++ks) { const bf16x8 a0 = *(LAS const bf16x8*)(Kt + fr * DK_STRIDE + (32 * ks + 8 * fq) * 2), a1 = *(LAS const bf16x8*)(Kt + (16 + fr) * DK_STRIDE + (32 * ks + 8 * fq) * 2);
                s0 = __builtin_amdgcn_mfma_f32_16x16x32_bf16(a0, qf[ks], s0, 0, 0, 0); s1 = __builtin_amdgcn_mfma_f32_16x16x32_bf16(a1, qf[ks], s1, 0, 0, 0); }
            float rm = __builtin_fmaxf(__builtin_fmaxf(__builtin_fmaxf(s0[0], s0[1]), __builtin_fmaxf(s0[2], s0[3])), __builtin_fmaxf(__builtin_fmaxf(s1[0], s1[1]), __builtin_fmaxf(s1[2], s1[3])));
            rm = xmax32(xmax16(rm));
            const float mnew = __builtin_fmaxf(m, rm); const float f = __builtin_amdgcn_exp2f(m - mnew); m = mnew;
#pragma unroll
            for (int e = 0; e < 4; ++e) { s0[e] = __builtin_amdgcn_exp2f(s0[e] - m); s1[e] = __builtin_amdgcn_exp2f(s1[e] - m); }
            l = l * f + ((s0[0] + s0[1]) + (s0[2] + s0[3])) + ((s1[0] + s1[1]) + (s1[2] + s1[3]));
            const v4u pw = (v4u){cvtpk(s0[0], s0[1]), cvtpk(s0[2], s0[3]), cvtpk(s1[0], s1[1]), cvtpk(s1[2], s1[3])}; const bf16x8 pb = __builtin_bit_cast(bf16x8, pw);
            lds_cptr vp = (lds_cptr)Kt + (4 * fq + (fr >> 2)) * DK_STRIDE + (fr & 3) * 8;
#pragma unroll
            for (int ct = 0; ct < 8; ++ct) { const s16x4 lo = vtr(vp + ct * 32), hh = vtr(vp + 16 * DK_STRIDE + ct * 32);
                const bf16x8 vf = (bf16x8){lo[0], lo[1], lo[2], lo[3], hh[0], hh[1], hh[2], hh[3]};
                o[ct] = o[ct] * f; o[ct] = __builtin_amdgcn_mfma_f32_16x16x32_bf16(vf, pb, o[ct], 0, 0, 0); }
            asm volatile("s_waitcnt lgkmcnt(0)" ::: "memory");
        } }
#undef DEC_LOAD
    l = xadd32(xadd16(l));
    __syncthreads();
    LAS float* OM = (LAS float*)lds;
    LAS float* Mw = (LAS float*)(lds + DEC_ML); LAS float* Lw = Mw + 8 * 16;
#pragma unroll
    for (int ct = 0; ct < 8; ++ct)
#pragma unroll
        for (int e = 0; e < 4; ++e) OM[(wid * 128 + 16 * ct + 4 * fq + e) * 16 + fr] = o[ct][e];
    if (fq == 0) { Mw[wid * 16 + fr] = m; Lw[wid * 16 + fr] = l; }
    __syncthreads();
    LAS float* OL = (LAS float*)(lds + DEC_OL);
    { const int q = tid & 15, t = q >> 2, cg = (tid >> 4) * 4;
      float sn[4]; float mm = -1e30f;
#pragma unroll
      for (int w = 0; w < 8; ++w) mm = __builtin_fmaxf(mm, Mw[w * 16 + q]);
      sn[0] = 0.f; sn[1] = 0.f; sn[2] = 0.f; sn[3] = 0.f;
#pragma unroll 8
      for (int d = 0; d < KVR; d += 2) { const unsigned qw = *(LAS const unsigned*)(Qs + q * DEC_QS_STRIDE + d * 2); const float x0 = bflo(qw), x1 = bfhi(qw);
#pragma unroll
          for (int s = 0; s < 4; ++s) { const f32x2 kv = *(const f32x2*)(nlat + s * KVR + d); sn[s] += x0 * kv[0] + x1 * kv[1]; } }
#pragma unroll 8
      for (int d = 0; d < QKR; d += 2) { const unsigned qw = *(LAS const unsigned*)(Qs + q * DEC_QS_STRIDE + 256 + d * 2); const float x0 = bflo(qw), x1 = bfhi(qw);
#pragma unroll
          for (int s = 0; s < 4; ++s) { const f32x2 kv = *(const f32x2*)(nkr + s * QKR + d); sn[s] += x0 * kv[0] + x1 * kv[1]; } }
#pragma unroll
      for (int s = 0; s < 4; ++s) { if (s > t) sn[s] = -INFINITY; mm = __builtin_fmaxf(mm, sn[s]); }
      float ls = 0.f; float acc[4] = {0.f, 0.f, 0.f, 0.f};
#pragma unroll
      for (int w = 0; w < 8; ++w) { const float fw = __builtin_amdgcn_exp2f(Mw[w * 16 + q] - mm); ls += Lw[w * 16 + q] * fw;
#pragma unroll
          for (int e = 0; e < 4; ++e) acc[e] += OM[(w * 128 + cg + e) * 16 + q] * fw; }
#pragma unroll
      for (int s = 0; s < 4; ++s) { const float ps = __builtin_amdgcn_exp2f(sn[s] - mm); ls += ps;
#pragma unroll
          for (int e = 0; e < 4; ++e) acc[e] += ps * nlat[s * KVR + cg + e]; }
      const float inv = 1.0f / ls;
#pragma unroll
      for (int e = 0; e < 4; ++e) OL[q * 128 + cg + e] = acc[e] * inv; }
    __syncthreads();
    { const int q = tid >> 5, t = q >> 2, h = q & 3, d = (tid & 31) * 2; float a0 = 0.f, a1 = 0.f;
#pragma unroll 16
      for (int c = 0; c < KVR; ++c) { const f32x2 w = *(const f32x2*)(wuv + (size_t)c * 256 + h * VHD + d); const float ov = OL[q * 128 + c]; a0 += ov * w[0]; a1 += ov * w[1]; }
      *(unsigned*)(YS + (size_t)(NPR + 4 * n + t) * DM + 512 + h * VHD + d) = pk2(a0, a1); }
    __syncthreads();
}
#undef ATT_WAIT_BAR
}

template <class Fn> struct HookT { static constexpr bool ON = true; const Fn& f; __device__ __forceinline__ void operator()() const { f(); } };
constexpr int NPHASE = 22;
struct Args { InRaw in; float* out; unsigned char* ws; int ph_lo, ph_hi; };
__global__ void __launch_bounds__(NWAVES * 64, 2) fwd(Args args) {
    extern __shared__ __attribute__((aligned(16))) unsigned char lds[];
    Frame F;
    F.lds = (LAS unsigned char*)lds;
    F.MISC = (volatile LAS unsigned*)(F.lds + MISC_OFF);
    F.tid = threadIdx.x; F.lane = F.tid & 63; F.wave = __builtin_amdgcn_readfirstlane(F.tid >> 6);
    F.G = gridDim.x; { const int bx = blockIdx.x; F.vcu = (F.G % 8 == 0) ? (bx % 8) * (F.G / 8) + bx / 8 : bx; }
    F.ws = args.ws; F.out = args.out; F.ctl = (gu32*)(args.ws + WS_CTL);
    for (int u = F.tid; u < (LDS_BYTES - LDSCTL_OFF) / 4; u += NWAVES * 64) ((LAS unsigned*)(F.lds + LDSCTL_OFF))[u] = 0u;
    __syncthreads();
    InPtrs I; I.tab = (const LAS unsigned long long*)(F.lds + INTAB_OFF);
    if (F.tid < 33) ((LAS unsigned long long*)(F.lds + INTAB_OFF))[F.tid] = (unsigned long long)args.in.p[F.tid];
    __syncthreads();
#if MK_ONE_LAUNCH
    XcdBarrier bar = xcd_barrier_post((unsigned*)(F.ctl + CW_BAR), F.MISC + 8);
#define GRID_BAR() xcd_barrier(bar)
#else
#define GRID_BAR() do {} while (0)
#endif
    const int lo = args.ph_lo, hi = args.ph_hi;
#ifndef PHMASK
#define PHMASK 0xFFFu
#endif
#define EN(id) ((((PHMASK) >> (id)) & 1u) != 0u)
#define IN(k) (lo <= (k) && (k) < hi)
#define BOTH(k) (IN(k) && IN((k) + 1))
#ifndef REPMASK
#define REPMASK 0u
#endif
#define NREP(id) (1 + (int)(((REPMASK) >> (id)) & 1u))
#define LFRAME() Frame Fl = F; { int t_ = F.tid; asm volatile("" : "+v"(t_)); Fl.tid = t_; Fl.lane = t_ & 63; Fl.wave = __builtin_amdgcn_readfirstlane(t_ >> 6); int g_ = F.G, v_ = F.vcu, b_ = (int)blockIdx.x; asm volatile("" : "+s"(g_), "+s"(v_), "+s"(b_)); Fl.G = g_; Fl.vcu = v_; Fl.bid = b_; }
#define WSP (args.ws)
#define HB ((pg8::bf16_t*)(args.ws + WS_HB))
#define T ((pg8::bf16_t*)(args.ws + WS_T))
#define Z ((pg8::bf16_t*)(args.ws + WS_Z))
#define QL ((pg8::bf16_t*)(args.ws + WS_QL))
#define QB ((pg8::bf16_t*)(args.ws + WS_QB))
#define KB ((pg8::bf16_t*)(args.ws + WS_KB))
#define VB ((pg8::bf16_t*)(args.ws + WS_VB))
#define YS ((pg8::bf16_t*)(args.ws + WS_YS))
#define MG ((pg8::bf16_t*)(args.ws + WS_MG))
#define PART ((float*)(args.ws + WS_PART))
#define SSQ ((float*)(args.ws + WS_SSQ))

    if (EN(0) && IN(0)) { for (int rep = 0; rep < NREP(0); ++rep) { LFRAME(); p0_prologue(Fl, I, NREP(0) == 2 && rep == 0); if (rep + 1 < NREP(0)) GRID_BAR(); } if (BOTH(0)) GRID_BAR(); }

    for (int L = 0; L < 2; ++L) {
        const int pb = 1 + 10 * L;
#define wl (args.ws + WS_WL + (size_t)L * WL_STRIDE)
        if (EN(1) && IN(pb + 0)) { for (int rep = 0; rep < NREP(1); ++rep) { LFRAME(); pg8::Gemm g{DM, DM, DM}; pg8::OrderAB<1> S; S.init(MROWS, 2 * DFF, Fl.G, Fl.bid); S.A = (const char*)HB; S.B = (const char*)(wl + WL_GU1); S.a_tile = (size_t)256 * DM * 2; S.b_tile = (size_t)256 * DM * 2; S.a_sub = 0; S.b_sub = 0;
            pg8::EpiSwiGLU E{T, SSQ + (size_t)(3 * L) * SSQ_STRIDE, (NREP(1) == 2 && rep == 0 && ((REPMASK >> 16) & 1u)) ? 1 : 0, (LAS float*)(F.lds + QTILE_OFF)};
            pg8::gemm_phase<pg8::EpiSwiGLU, pg8::OrderAB<1>, true, true>(F.lds + RING_OFF, g, S, E);
            if (rep + 1 == NREP(1)) { if (L == 0) conv_drain_queue<1>(Fl, I, F.ctl + CW_CONVQ); else conv_drain_queue<4>(Fl, I, F.ctl + CW_CONVQ + 192); }
            if (rep + 1 < NREP(1)) GRID_BAR(); }
            if (BOTH(pb + 0)) GRID_BAR(); }
        if (EN(2) && IN(pb + 1)) { for (int rep = 0; rep < NREP(2); ++rep) { const bool dm = rep + 1 < NREP(2); LFRAME(); pg8::Gemm g{DFF, DFF, DFF}; pg8::OrderAB<1> S; S.init(NPR, DM, Fl.G, Fl.bid); S.A = (const char*)T; S.B = (const char*)(wl + WL_D1); S.a_tile = (size_t)256 * DFF * 2; S.b_tile = (size_t)256 * DFF * 2; S.a_sub = 0; S.b_sub = 0;
            pg8::EpiRes E{dm ? (pg8::bf16_t*)(WSP + WS_DUMH) : HB, dm ? (float*)(WSP + WS_DUMS) : SSQ + (size_t)(3 * L + 1) * SSQ_STRIDE, 0.5f};
            { MiniRes ME{dm ? (bf16*)(WSP + WS_DUMH) : (bf16*)HB, dm ? (float*)(WSP + WS_DUMS) : SSQ + (size_t)(3 * L + 1) * SSQ_STRIDE, 0.5f};
              auto hk = [&]() { mini_gemm<false>(F.lds + RING_OFF, (const bf16*)T + (size_t)NPR * DFF, DFF, (const bf16*)(wl + WL_D1), DFF, DFF, 0, 0, nullptr, ME, Fl.vcu, Fl.G); };
              pg8::gemm_phase<pg8::EpiRes, pg8::OrderAB<1>, true, true, HookT<decltype(hk)>>(F.lds + RING_OFF, g, S, E, HookT<decltype(hk)>{hk}); }
            if (dm) GRID_BAR(); }
            if (BOTH(pb + 1)) GRID_BAR(); }
        if (EN(3) && IN(pb + 2)) { for (int rep = 0; rep < NREP(3); ++rep) { LFRAME(); pg8::Gemm g{DM, DM, DM}; pg8::OrderAB<1> S; S.init(MROWS, INP, Fl.G, Fl.bid); S.A = (const char*)HB; S.B = (const char*)(wl + WL_IN); S.a_tile = (size_t)256 * DM * 2; S.b_tile = (size_t)256 * DM * 2; S.a_sub = 0; S.b_sub = 0;
            pg8::EpiZ E{Z, SSQ + (size_t)(3 * L + 1) * SSQ_STRIDE, (LAS float*)(F.lds + QTILE_OFF)};
            pg8::gemm_phase<pg8::EpiZ, pg8::OrderAB<1>, true, true>(F.lds + RING_OFF, g, S, E);
            if (rep + 1 == NREP(3)) { if (L == 0) conv_drain_queue<2>(Fl, I, F.ctl + CW_CONVQ + 64); else conv_drain_queue<5>(Fl, I, F.ctl + CW_CONVQ + 256); }
            if (rep + 1 < NREP(3)) GRID_BAR(); }
            if (BOTH(pb + 2)) GRID_BAR(); }
        if (EN(4) && IN(pb + 3)) { for (int rep = 0; rep < NREP(4); ++rep) { LFRAME(); p_prep(Fl, I, L); if (rep + 1 < NREP(4)) GRID_BAR(); } if (BOTH(pb + 3)) GRID_BAR(); }
        if (EN(5) && IN(pb + 4)) { for (int rep = 0; rep < NREP(5); ++rep) { LFRAME(); pg8::Gemm g{384, 384, 384}; pg8::OrderAB<1> S; S.init(NPR, 1024, Fl.G, Fl.bid); S.A = (const char*)QL; S.B = (const char*)(WSP + WS_WCAT + (size_t)L * WCAT_BYTES); S.a_tile = (size_t)256 * 384 * 2; S.b_tile = (size_t)256 * 384 * 2; S.a_sub = 0; S.b_sub = 0;
            pg8::EpiMla E{QB, KB, VB, (const float*)(WSP + WS_ROPE)};
            { MiniMla ME{(bf16*)QB, (bf16*)KB, (bf16*)VB, (const float*)(WSP + WS_ROPE)};
              auto hk = [&]() { mini_gemm<false>(F.lds + RING_OFF, (const bf16*)QL + (size_t)NPR * 384, 384, (const bf16*)(WSP + WS_WCAT + (size_t)L * WCAT_BYTES), 384, 384, 0, 0, nullptr, ME, Fl.vcu, Fl.G); };
              pg8::gemm_phase<pg8::EpiMla, pg8::OrderAB<1>, true, true, HookT<decltype(hk)>>(F.lds + RING_OFF, g, S, E, HookT<decltype(hk)>{hk}); }
            if (rep + 1 < NREP(5)) GRID_BAR(); }
            if (BOTH(pb + 4)) GRID_BAR(); }
        if (EN(6) && IN(pb + 5)) { for (int rep = 0; rep < NREP(6); ++rep) { LFRAME();
            if (!(rep == 1 && ((REPMASK >> 13) & 1u))) if ((Fl.vcu & 1) == 0) for (int n = Fl.vcu >> 1; n < NSEQ_S; n += (Fl.G + 1) >> 1) att::decode_seq(n, L, I, (const bf16*)QB, F.out, (bf16*)YS, F.lds + RING_OFF);
            const int home = (int)(xb_xcc_id() & 7u);
            for (int kq = 0; kq < 8; ++kq) { const int bh = (home + kq) & 7;
                gu32* qh = F.ctl + CW_Q + ((L * 2 + rep) * 8 + bh) * 64;
                for (;;) {
                    __syncthreads();
                    if (Fl.tid == 0) F.MISC[0] = __hip_atomic_fetch_add(qh, 1u, RLX_AGENT);
                    __syncthreads();
                    const int item = (int)F.MISC[0];
                    if (item >= 64 || (rep == 1 && ((REPMASK >> 12) & 1u))) break;
                    att::flash_unit(bh >> 2, bh & 3, 63 - item, (const bf16*)QB, (const bf16*)KB, (const bf16*)VB, (bf16*)YS, F.lds + RING_OFF);
                } }
            if (rep + 1 < NREP(6)) GRID_BAR(); }
            if (BOTH(pb + 5)) GRID_BAR(); }
        if (EN(7) && IN(pb + 6)) { for (int rep = 0; rep < NREP(7); ++rep) { LFRAME(); pg8::Gemm g{DM, BRW, BRW}; pg8::OrderAB<4> S; S.init(NPR, DM, Fl.G, Fl.bid); S.A = (const char*)YS; S.B = (const char*)(wl + WL_BR); S.a_tile = (size_t)256 * DM * 2; S.b_tile = (size_t)256 * BRW * 2; S.a_sub = (size_t)BRW * 2; S.b_sub = (size_t)DM * BRW * 2;
            pg8::EpiBranch E{Z, MG};
            { MiniBranch ME{(bf16*)MG};
              auto hk = [&]() { mini_gemm<true>(F.lds + RING_OFF, (const bf16*)YS + (size_t)NPR * DM, DM, (const bf16*)(wl + WL_BR), BRW, BRW, (size_t)BRW, (size_t)DM * BRW, (const bf16*)Z, ME, Fl.vcu, Fl.G); };
              pg8::gemm_phase<pg8::EpiBranch, pg8::OrderAB<4>, true, true, HookT<decltype(hk)>>(F.lds + RING_OFF, g, S, E, HookT<decltype(hk)>{hk}); }
            if (rep + 1 < NREP(7)) GRID_BAR(); }
            if (BOTH(pb + 6)) GRID_BAR(); }
        if (EN(8) && IN(pb + 7)) { for (int rep = 0; rep < NREP(8); ++rep) { const bool dm = rep + 1 < NREP(8); LFRAME(); pg8::Gemm g{DM, DM, DM}; pg8::OrderAB<1> S; S.init(NPR, DM, Fl.G, Fl.bid); S.A = (const char*)MG; S.B = (const char*)(wl + WL_O); S.a_tile = (size_t)256 * DM * 2; S.b_tile = (size_t)256 * DM * 2; S.a_sub = 0; S.b_sub = 0;
            pg8::EpiRes E{dm ? (pg8::bf16_t*)(WSP + WS_DUMH) : HB, dm ? (float*)(WSP + WS_DUMS) : SSQ + (size_t)(3 * L + 2) * SSQ_STRIDE, 1.0f};
            { MiniRes ME{dm ? (bf16*)(WSP + WS_DUMH) : (bf16*)HB, dm ? (float*)(WSP + WS_DUMS) : SSQ + (size_t)(3 * L + 2) * SSQ_STRIDE, 1.0f};
              auto hk = [&]() { mini_gemm<false>(F.lds + RING_OFF, (const bf16*)MG + (size_t)NPR * DM, DM, (const bf16*)(wl + WL_O), DM, DM, 0, 0, nullptr, ME, Fl.vcu, Fl.G); };
              pg8::gemm_phase<pg8::EpiRes, pg8::OrderAB<1>, true, true, HookT<decltype(hk)>>(F.lds + RING_OFF, g, S, E, HookT<decltype(hk)>{hk}); }
            if (dm) GRID_BAR(); }
            if (BOTH(pb + 7)) GRID_BAR(); }
        if (EN(9) && IN(pb + 8)) { for (int rep = 0; rep < NREP(9); ++rep) { LFRAME(); pg8::Gemm g{DM, DM, DM}; pg8::OrderAB<1> S; S.init(MROWS, 2 * DFF, Fl.G, Fl.bid); S.A = (const char*)HB; S.B = (const char*)(wl + WL_GU2); S.a_tile = (size_t)256 * DM * 2; S.b_tile = (size_t)256 * DM * 2; S.a_sub = 0; S.b_sub = 0;
            pg8::EpiSwiGLU E{T, SSQ + (size_t)(3 * L + 2) * SSQ_STRIDE, 0, (LAS float*)(F.lds + QTILE_OFF)};
            pg8::gemm_phase<pg8::EpiSwiGLU, pg8::OrderAB<1>, true, true>(F.lds + RING_OFF, g, S, E);
            if (L == 0 && rep + 1 == NREP(9)) conv_drain_queue<3>(Fl, I, F.ctl + CW_CONVQ + 128);
            if (rep + 1 < NREP(9)) GRID_BAR(); }
            if (BOTH(pb + 8)) GRID_BAR(); }
        if (EN(10) && IN(pb + 9)) { for (int rep = 0; rep < NREP(10); ++rep) { const bool dm = rep + 1 < NREP(10); LFRAME(); pg8::Gemm g{DFF, DFF, DFF}; pg8::OrderAB<1> S; S.init(NPR, DM, Fl.G, Fl.bid); S.A = (const char*)T; S.B = (const char*)(wl + WL_D2); S.a_tile = (size_t)256 * DFF * 2; S.b_tile = (size_t)256 * DFF * 2; S.a_sub = 0; S.b_sub = 0;
            pg8::EpiRes E{dm ? (pg8::bf16_t*)(WSP + WS_DUMH) : HB, dm ? (float*)(WSP + WS_DUMS) : SSQ + (size_t)(3 * L + 3) * SSQ_STRIDE, 0.5f};
            { MiniRes ME{dm ? (bf16*)(WSP + WS_DUMH) : (bf16*)HB, dm ? (float*)(WSP + WS_DUMS) : SSQ + (size_t)(3 * L + 3) * SSQ_STRIDE, 0.5f};
              auto hk = [&]() { mini_gemm<false>(F.lds + RING_OFF, (const bf16*)T + (size_t)NPR * DFF, DFF, (const bf16*)(wl + WL_D2), DFF, DFF, 0, 0, nullptr, ME, Fl.vcu, Fl.G); };
              pg8::gemm_phase<pg8::EpiRes, pg8::OrderAB<1>, true, true, HookT<decltype(hk)>>(F.lds + RING_OFF, g, S, E, HookT<decltype(hk)>{hk}); }
            if (dm) GRID_BAR(); }
            if (BOTH(pb + 9)) GRID_BAR(); }
    }
    if (EN(11) && IN(21)) { LFRAME(); p_final(Fl, I); }
#undef IN
#undef BOTH
#undef WSP
#undef HB
#undef T
#undef Z
#undef QL
#undef QB
#undef KB
#undef VB
#undef YS
#undef MG
#undef PART
#undef SSQ
#undef wl
}

extern "C" void kernel_launch(void* const* d_in, const int* in_sizes, int n_in, void* d_out, int out_size, void* d_ws, size_t ws_size, hipStream_t stream) {
    static int grid = 0;
    if (grid == 0) {
        if (n_in != 33 || (size_t)out_size != OUT_TOTAL || ws_size < WS_END) { fprintf(stderr, "kernel_launch: unexpected problem shape (n_in %d, out %d, ws %zu); nothing launched\n", n_in, out_size, ws_size); grid = -1; return; }
        int dev = 0, cus = 0, per_cu = 0;
        if (hipGetDevice(&dev) != hipSuccess || hipDeviceGetAttribute(&cus, hipDeviceAttributeMultiprocessorCount, dev) != hipSuccess) { grid = -1; return; }
        if (hipFuncSetAttribute((const void*)fwd, hipFuncAttributeMaxDynamicSharedMemorySize, LDS_BYTES) != hipSuccess) { fprintf(stderr, "kernel_launch: hipFuncSetAttribute failed\n"); grid = -1; return; }
        if (hipOccupancyMaxActiveBlocksPerMultiprocessor(&per_cu, (const void*)fwd, NWAVES * 64, LDS_BYTES) != hipSuccess || per_cu < 1) { fprintf(stderr, "kernel_launch: occupancy query reports %d workgroups per CU\n", per_cu); }
        (void)hipGetLastError();
        grid = cus;
    }
    if (grid < 0) return;
    if (hipMemsetAsync((char*)d_ws + WS_CTL, 0, CTL_ZERO_BYTES, stream) != hipSuccess) { fprintf(stderr, "kernel_launch: hipMemsetAsync failed\n"); return; }
    Args a{};
    for (int i = 0; i < 33; ++i) a.in.p[i] = (const float*)d_in[i];
    a.out = (float*)d_out; a.ws = (unsigned char*)d_ws;
#if MK_ONE_LAUNCH
    a.ph_lo = 0; a.ph_hi = NPHASE;
    hipLaunchKernelGGL(fwd, dim3(grid), dim3(NWAVES * 64), LDS_BYTES, stream, a);
#else
    for (int ph = 0; ph < NPHASE; ++ph) { a.ph_lo = ph; a.ph_hi = ph + 1; hipLaunchKernelGGL(fwd, dim3(grid), dim3(NWAVES * 64), LDS_BYTES, stream, a); }
#endif
    const hipError_t le = hipPeekAtLastError();
    if (le != hipSuccess) fprintf(stderr, "kernel_launch: launch failed: %s\n", hipGetErrorName(le));
}
```

```cpp
#include <hip/hip_runtime.h>
#include <hip/hip_bf16.h>
#include <cstdio>
#include <cstdint>

#ifndef MK_ONE_LAUNCH
#define MK_ONE_LAUNCH 1
#endif

constexpr int DM = 1024, NPR = 16384, NSR = 512, MROWS = 16896, SEQ = 8192, DFF = 2816, INC = 6304, INP = 6400, BRW = 256;
constexpr int NSEQ_S = 128, TS = 4, NPAGES = 64, PAGE = 128, NPOOL = 10240, KVR = 128, QKR = 32, QKN = 64, QKD = 96, VHD = 64, NHEAD = 4;
constexpr int ZC_AH = 0, ZC_AC = 256, ZC_AB = 512, ZC_BU = 768, ZC_BV = 1024, ZC_CQ = 1280, ZC_CKV = 1536, ZC_CKR = 1664, ZC_DV = 1696, ZC_DG = 1952, ZC_GATE = 2208;
constexpr float RMS_EPS = 1e-6f, LN_EPS = 1e-5f;
constexpr float ATT_C2 = 0.10206207261596575f * 1.4426950408889634f;
__host__ __device__ __forceinline__ size_t kt_off(int row, int h, int d) { const int b = row >> 13, tl = row & (SEQ - 1); return ((size_t)(b * 4 + h) * SEQ + (size_t)(tl & ~63)) * 96 + (size_t)(d >> 3) * 512 + (tl & 63) * 8 + (d & 7); }
__host__ __device__ __forceinline__ size_t vt_off(int row, int h, int d) { const int b = row >> 13, tl = row & (SEQ - 1); return ((size_t)(b * 4 + h) * SEQ + (size_t)(tl & ~63)) * 64 + (size_t)((d >> 5) * 4 + ((tl & 63) >> 4)) * 512 + (tl & 15) * 32 + (d & 31); }
constexpr size_t OFF_YP = 0, OFF_YS = 16777216, OFF_LATP = 17301504, OFF_KRP = 21495808, OFF_CAP = 22544384, OFF_CDP = 22546432,
                 OFF_LATS = 22577152, OFF_KRS = 22708224, OFF_CAS = 22740992, OFF_CDS = 22872064, OFF_VS = 24838144, OUT_TOTAL = 25100288;

constexpr size_t MiB = 1u << 20;
constexpr size_t WS_CTL = 0, CTL_ZERO_BYTES = 4 * MiB;
constexpr size_t WS_WCAT = 2 * MiB, WCAT_BYTES = 1024 * 384 * 2;
constexpr size_t WS_ROPE = 4 * MiB, WS_WSB = 6 * MiB;
constexpr size_t WS_WL = 8 * MiB, WL_STRIDE = 64 * MiB;
constexpr size_t WL_GU1 = 0, WL_D1 = 12 * MiB, WL_IN = 18 * MiB, WL_BR = 31 * MiB, WL_O = 33 * MiB, WL_GU2 = 35 * MiB, WL_D2 = 47 * MiB;
constexpr size_t WS_HB = 144 * MiB, WS_T = 178 * MiB, WS_Z = 272 * MiB, WS_QL = 480 * MiB, WS_QB = 496 * MiB, WS_KB = 512 * MiB, WS_VB = 528 * MiB,
                 WS_YS = 544 * MiB, WS_MG = 580 * MiB, WS_PART = 616 * MiB, WS_SSQ = 684 * MiB  , WS_DUMH = 704 * MiB, WS_DUMS = 740 * MiB  , WS_END = 760 * MiB;
constexpr size_t SSQ_STRIDE = (size_t)MROWS * 16;
constexpr int CW_TMO = 0, CW_CODE = 1, CW_BAR = 4096, CW_Q = 8192, CW_CONVQ = 12288;

constexpr int RING_OFF = 0, RING_BYTES = 131072;
constexpr int LDSCTL_OFF = RING_BYTES, MISC_OFF = LDSCTL_OFF + 320, INTAB_OFF = LDSCTL_OFF + 1024;
constexpr int LDS_BYTES = 163840;
constexpr int QTILE_OFF = LDSCTL_OFF + 2048, QT_STRIDE = 208;
constexpr int NWAVES = 8;

#define GAS __attribute__((address_space(1)))
#define LAS __attribute__((address_space(3)))

template <int CTRL> __device__ __forceinline__ float xl_dpp(float v) { return __builtin_bit_cast(float, __builtin_amdgcn_update_dpp(0, __builtin_bit_cast(int, v), CTRL, 0xf, 0xf, true)); }
__device__ __forceinline__ float xadd1(float v) { return v + xl_dpp<0xB1>(v); }
__device__ __forceinline__ float xadd2(float v) { return v + xl_dpp<0x4E>(v); }
__device__ __forceinline__ float xadd4(float v) { return v + xl_dpp<0x141>(v); }
__device__ __forceinline__ float xadd8(float v) { return v + xl_dpp<0x140>(v); }
__device__ __forceinline__ void xswap16(float& a, float& b) { asm volatile("s_nop 1\n\tv_permlane16_swap_b32 %0, %1\n\ts_nop 1" : "+v"(a), "+v"(b)); }
__device__ __forceinline__ void xswap32(float& a, float& b) { asm volatile("s_nop 1\n\tv_permlane32_swap_b32 %0, %1\n\ts_nop 1" : "+v"(a), "+v"(b)); }
__device__ __forceinline__ float xadd16(float v) { float a = v, b = v; xswap16(a, b); return a + b; }
__device__ __forceinline__ float xadd32(float v) { float a = v, b = v; xswap32(a, b); return a + b; }
__device__ __forceinline__ float xmax16(float v) { float a = v, b = v; xswap16(a, b); return __builtin_fmaxf(a, b); }
__device__ __forceinline__ float xmax32(float v) { float a = v, b = v; xswap32(a, b); return __builtin_fmaxf(a, b); }

namespace pg8 {
#define PG8_LAS __attribute__((address_space(3)))
typedef unsigned short bf16_t;
typedef short bf16x8 __attribute__((ext_vector_type(8)));
typedef float f32x4 __attribute__((ext_vector_type(4)));
typedef float f32x2 __attribute__((ext_vector_type(2)));
typedef unsigned u32x4 __attribute__((ext_vector_type(4)));
typedef unsigned u32x2 __attribute__((ext_vector_type(2)));
constexpr int BM = 256, BK = 64, HALF = 128, HTB = HALF * BK * 2  , STAGE_BYTES = 8 * HTB, NXCD = 8, WGM = 8;

__host__ __device__ __forceinline__ int lds_byte(int r, int c) { const int st = (r >> 4) * 2 + (c >> 5), rr = r & 15, cc = c & 31, ob = rr * 64 + cc * 2; return st * 1024 + (ob ^ (((ob >> 9) & 1) << 5)); }
__host__ __device__ __forceinline__ void stage_rc(int b, int& R, int& C) { const int st = b / 1024, sb = b % 1024, swz = sb ^ (((sb >> 9) & 1) << 5); R = (st >> 1) * 16 + swz / 64; C = (st & 1) * 32 + (swz % 64) / 2; }
__host__ __device__ __forceinline__ int perm32(int rho) { const int n = rho >> 4, i = rho & 15; return 8 * (i >> 2) + 4 * n + (i & 3); }

struct Unit { int pm, pn, sub; };
struct Gemm { int lda, ldb, K; };

template <int NSUB> struct OrderAB {
    int nM, nN, nwg, G, c;
    const char* A; const char* B; size_t a_tile, b_tile, a_sub, b_sub;
    __device__ void init(int M, int N, int G_, int c_) { nM = M / BM; nN = N / BM; nwg = nM * nN; G = G_; c = c_; }
    __device__ bool next(int i, Unit& u) const {
        const int ib = i / NSUB; u.sub = i - ib * NSUB;
        const long L = (long)ib * G + c; if (L >= nwg) return false;
        int wgid = (int)L; { const int q = nwg / NXCD, r = nwg % NXCD, xcd = wgid % NXCD, off = wgid / NXCD; wgid = (xcd < r ? xcd * (q + 1) : r * (q + 1) + (xcd - r) * q) + off; }
        const int nig = WGM * nN, gid = wgid / nig, fm = gid * WGM, gsz = (nM - fm) < WGM ? (nM - fm) : WGM;
        u.pm = fm + ((wgid % nig) % gsz); u.pn = (wgid % nig) / gsz; return true;
    }
    __device__ __forceinline__ const char* a_ptr(const Unit& u) const { return A + (size_t)u.pm * a_tile + (size_t)u.sub * a_sub; }
    __device__ __forceinline__ const char* b_ptr(const Unit& u) const { return B + (size_t)u.pn * b_tile + (size_t)u.sub * b_sub; }
    __device__ __forceinline__ void a_ready(const Unit&) const {}
    __device__ __forceinline__ void done(const Unit&) const {}
};

__device__ __forceinline__ unsigned cvt_pk_bf16(float lo, float hi) { unsigned r; asm volatile("v_cvt_pk_bf16_f32 %0, %1, %2" : "=v"(r) : "v"(lo), "v"(hi)); return r; }
__device__ __forceinline__ float bf_lo(unsigned w) { return __uint_as_float(w << 16); }
__device__ __forceinline__ float bf_hi(unsigned w) { return __uint_as_float(w & 0xffff0000u); }
__device__ __forceinline__ float silu_f(float x) { return x * __builtin_amdgcn_rcpf(1.f + __builtin_amdgcn_exp2f(-1.4426950408889634f * x)); }
__device__ __forceinline__ float sigmoid_f(float x) { return __builtin_amdgcn_rcpf(1.f + __builtin_amdgcn_exp2f(-1.4426950408889634f * x)); }

__device__ __forceinline__ float row_rstd(const float* ssq, int row, int fq) {
    const f32x4 q = *(const f32x4*)(ssq + (size_t)row * 16 + 4 * fq); float s = (q[0] + q[1]) + (q[2] + q[3]); s = xadd32(xadd16(s));
    return __builtin_amdgcn_rsqf(s * (1.0f / DM) + RMS_EPS); }
__device__ __forceinline__ void row_rstd8(const float* ssq, int row0, int fq, float (&rs)[8]) {
#pragma unroll
    for (int k = 0; k < 8; ++k) { const f32x4 q = *(const f32x4*)(ssq + (size_t)(row0 + (k >> 2) * HALF + (k & 3) * 16) * 16 + 4 * fq); rs[k] = (q[0] + q[1]) + (q[2] + q[3]); }
#pragma unroll
    for (int k = 0; k < 8; ++k) rs[k] = xadd32(xadd16(rs[k]));
#pragma unroll
    for (int k = 0; k < 8; ++k) rs[k] = __builtin_amdgcn_rsqf(rs[k] * (1.0f / DM) + RMS_EPS);
}
#define PG8_PRE_FUNCS \
    __device__ __forceinline__ void pre_load(const Unit& u, int wr, int wc, int fr, int fq, f32x4 (&pq)[2]) const { const int row0 = u.pm * BM + wr * 64 + fr; \
        _Pragma("unroll") for (int k2 = 0; k2 < 2; ++k2) { const int k = 2 * wc + k2; pq[k2] = *(const f32x4*)(ssq + (size_t)(row0 + (k >> 2) * HALF + (k & 3) * 16) * 16 + 4 * fq); } } \
    __device__ __forceinline__ void pre_commit(const f32x4 (&pq)[2], int wr, int wc, int fr, int fq, int par) const { float rs[2]; \
        _Pragma("unroll") for (int k = 0; k < 2; ++k) rs[k] = (pq[k][0] + pq[k][1]) + (pq[k][2] + pq[k][3]); \
        _Pragma("unroll") for (int k = 0; k < 2; ++k) rs[k] = xadd32(xadd16(rs[k])); \
        _Pragma("unroll") for (int k = 0; k < 2; ++k) rs[k] = __builtin_amdgcn_rsqf(rs[k] * (1.0f / DM) + RMS_EPS); \
        if (fq == 0) *(PG8_LAS f32x2*)(pre + par * 256 + (wr * 16 + fr) * 8 + 2 * wc) = (f32x2){rs[0], rs[1]}; } \
    __device__ __forceinline__ void pre_get(int wr, int fr, int par, float (&rs)[8]) const { PG8_LAS const float* p = pre + par * 256 + (wr * 16 + fr) * 8; \
        const f32x4 a = *(PG8_LAS const f32x4*)p, b = *(PG8_LAS const f32x4*)(p + 4); rs[0] = a[0]; rs[1] = a[1]; rs[2] = a[2]; rs[3] = a[3]; rs[4] = b[0]; rs[5] = b[1]; rs[6] = b[2]; rs[7] = b[3]; }

struct EpiSwiGLU {
    static constexpr bool PERM = true, AFTER_DRAIN = false, KEEP_ACC = false, HAS_INIT = false, HAS_PRE = true; __device__ __forceinline__ bool keep(const Unit&) const { return false; }
    bf16_t* T; const float* ssq; int ex = 0; PG8_LAS float* pre = nullptr;
    PG8_PRE_FUNCS
    __device__ __forceinline__ void operator()(const f32x4 (&acc)[2][2][4][2], const Unit& u, int wr, int wc, int fr, int fq, int par) const {
        asm volatile("" : "+v"(fr), "+v"(fq));
        const int row0 = u.pm * BM + wr * 64 + fr, col0 = u.pn * 128 + wc * 32 + 8 * fq; float rs8[8]; pre_get(wr, fr, par, rs8);
#pragma unroll
        for (int ai = 0; ai < 2; ++ai)
#pragma unroll
            for (int m = 0; m < 4; ++m) { const int row = row0 + ai * HALF + m * 16; const float rs = rs8[ai * 4 + m];
                f32x4 g0 = acc[ai][0][m][0] * rs, g1 = acc[ai][0][m][1] * rs, u0 = acc[ai][1][m][0] * rs, u1 = acc[ai][1][m][1] * rs;
                u32x4 w;
                if (ex) { w.x = cvt_pk_bf16(g0[0] * u0[0], g0[1] * u0[1]); w.y = cvt_pk_bf16(g0[2] * u0[2], g0[3] * u0[3]); w.z = cvt_pk_bf16(g1[0] * u1[0], g1[1] * u1[1]); w.w = cvt_pk_bf16(g1[2] * u1[2], g1[3] * u1[3]); } else {
                w.x = cvt_pk_bf16(silu_f(g0[0]) * u0[0], silu_f(g0[1]) * u0[1]); w.y = cvt_pk_bf16(silu_f(g0[2]) * u0[2], silu_f(g0[3]) * u0[3]);
                w.z = cvt_pk_bf16(silu_f(g1[0]) * u1[0], silu_f(g1[1]) * u1[1]); w.w = cvt_pk_bf16(silu_f(g1[2]) * u1[2], silu_f(g1[3]) * u1[3]); }
                *(u32x4*)(T + (size_t)row * DFF + col0) = w; }
    }
};
struct EpiZ {
    static constexpr bool PERM = true, AFTER_DRAIN = false, KEEP_ACC = false, HAS_INIT = false, HAS_PRE = true; __device__ __forceinline__ bool keep(const Unit&) const { return false; }
    bf16_t* Z; const float* ssq; PG8_LAS float* pre = nullptr;
    PG8_PRE_FUNCS
    __device__ __forceinline__ void operator()(const f32x4 (&acc)[2][2][4][2], const Unit& u, int wr, int wc, int fr, int fq, int par) const {
        asm volatile("" : "+v"(fr), "+v"(fq));
        const int row0 = u.pm * BM + wr * 64 + fr, col0 = u.pn * BM + wc * 32 + 8 * fq; const bool any_gate = (u.pn * BM + BM) > ZC_GATE; float rs8[8]; pre_get(wr, fr, par, rs8);
#pragma unroll
        for (int ai = 0; ai < 2; ++ai)
#pragma unroll
            for (int m = 0; m < 4; ++m) { const int row = row0 + ai * HALF + m * 16; const float rs = rs8[ai * 4 + m];
                bf16_t* rowp = Z + (size_t)row * INP + col0;
#pragma unroll
                for (int bj = 0; bj < 2; ++bj) { f32x4 v0 = acc[ai][bj][m][0] * rs, v1 = acc[ai][bj][m][1] * rs;
                    if (any_gate) { if (col0 + bj * HALF >= ZC_GATE) {
#pragma unroll
                        for (int e = 0; e < 4; ++e) { v0[e] = __builtin_fmaxf(sigmoid_f(v0[e]), 1e-20f); v1[e] = __builtin_fmaxf(sigmoid_f(v1[e]), 1e-20f); } } }
                    u32x4 w; w.x = cvt_pk_bf16(v0[0], v0[1]); w.y = cvt_pk_bf16(v0[2], v0[3]); w.z = cvt_pk_bf16(v1[0], v1[1]); w.w = cvt_pk_bf16(v1[2], v1[3]);
                    *(u32x4*)(rowp + bj * HALF) = w; } }
    }
};
struct EpiRes {
    static constexpr bool PERM = true, AFTER_DRAIN = false, KEEP_ACC = false, HAS_INIT = true, HAS_PRE = false; __device__ __forceinline__ bool keep(const Unit&) const { return false; }
    bf16_t* hb; float* ssq_out; float scale;
    __device__ __forceinline__ void init(f32x4 (&acc)[2][2][4][2], const Unit& u, int wr, int wc, int fr, int fq) const {
        const int row0 = u.pm * BM + wr * 64 + fr, col0 = u.pn * BM + wc * 32 + 8 * fq; const float inv = 1.0f / scale;
#pragma unroll
        for (int ai = 0; ai < 2; ++ai)
#pragma unroll
            for (int m = 0; m < 4; ++m) { const bf16_t* bp = hb + (size_t)(row0 + ai * HALF + m * 16) * DM + col0;
#pragma unroll
                for (int bj = 0; bj < 2; ++bj) { const u32x4 w = *(const u32x4*)(bp + bj * HALF);
                    acc[ai][bj][m][0] = (f32x4){bf_lo(w.x), bf_hi(w.x), bf_lo(w.y), bf_hi(w.y)} * inv; acc[ai][bj][m][1] = (f32x4){bf_lo(w.z), bf_hi(w.z), bf_lo(w.w), bf_hi(w.w)} * inv; } }
    }
    __device__ __forceinline__ void operator()(const f32x4 (&acc)[2][2][4][2], const Unit& u, int wr, int wc, int fr, int fq) const {
        asm volatile("" : "+v"(fr), "+v"(fq));
        const int row0 = u.pm * BM + wr * 64 + fr, col0 = u.pn * BM + wc * 32 + 8 * fq;
#pragma unroll
        for (int ai = 0; ai < 2; ++ai)
#pragma unroll
            for (int m = 0; m < 4; ++m) { const int row = row0 + ai * HALF + m * 16; bf16_t* hp = hb + (size_t)row * DM + col0; float sq = 0.f;
#pragma unroll
                for (int bj = 0; bj < 2; ++bj) { const f32x4 o0 = acc[ai][bj][m][0] * scale, o1 = acc[ai][bj][m][1] * scale;
                    sq += ((o0[0] * o0[0] + o0[1] * o0[1]) + (o0[2] * o0[2] + o0[3] * o0[3])) + ((o1[0] * o1[0] + o1[1] * o1[1]) + (o1[2] * o1[2] + o1[3] * o1[3]));
                    u32x4 w; w.x = cvt_pk_bf16(o0[0], o0[1]); w.y = cvt_pk_bf16(o0[2], o0[3]); w.z = cvt_pk_bf16(o1[0], o1[1]); w.w = cvt_pk_bf16(o1[2], o1[3]); *(u32x4*)(hp + bj * HALF) = w; }
                sq = xadd32(xadd16(sq));
                if (fq == 0) ssq_out[(size_t)row * 16 + u.pn * 4 + wc] = sq; }
    }
};
struct EpiMla {
    static constexpr bool PERM = false, AFTER_DRAIN = false, KEEP_ACC = false, HAS_INIT = false, HAS_PRE = false; __device__ __forceinline__ bool keep(const Unit&) const { return false; }
    bf16_t* Qb; bf16_t* Kb; bf16_t* Vb; const float* rope;
    __device__ __forceinline__ void operator()(const f32x4 (&acc)[2][2][4][2], const Unit& u, int wr, int wc, int fr, int fq) const {
        asm volatile("" : "+v"(fr), "+v"(fq));
        const int row0 = u.pm * BM + wr * 64 + fr;
#pragma unroll
        for (int bj = 0; bj < 2; ++bj) { const int cb = u.pn * BM + bj * HALF;
            if (cb >= 896) continue;
            const int g32 = (cb >> 5) + wc; const bool is_pe = (cb < 384) && (g32 % 3 == 2);
#pragma unroll
            for (int ai = 0; ai < 2; ++ai) {
            f32x4 csA[4], snA[4];
            if (is_pe) {
#pragma unroll
                for (int k = 0; k < 4; ++k) { const int row = row0 + ai * HALF + k * 16; const int pos = row < NPR ? (row & (SEQ - 1)) : SEQ + (row & 3);
                    csA[k] = *(const f32x4*)(rope + (size_t)pos * 32 + 4 * fq); snA[k] = *(const f32x4*)(rope + (size_t)pos * 32 + 16 + 4 * fq); }
                asm volatile("" : "+v"(csA[0]), "+v"(csA[1]), "+v"(csA[2]), "+v"(csA[3]), "+v"(snA[0]), "+v"(snA[1]), "+v"(snA[2]), "+v"(snA[3])); }
#pragma unroll
                for (int m = 0; m < 4; ++m) { const int row = row0 + ai * HALF + m * 16;
                    f32x4 v0 = acc[ai][bj][m][0], v1 = acc[ai][bj][m][1];
                    const int c0 = cb + wc * 32 + 4 * fq;
                    if (cb < 384) {
                        if (is_pe) { const f32x4 cs = csA[m], sn = snA[m];
                            const f32x4 a = v0 * cs - v1 * sn, b = v1 * cs + v0 * sn; v0 = a; v1 = b; }
                        v0 = v0 * ATT_C2; v1 = v1 * ATT_C2;
                        u32x2 w0, w1; w0.x = cvt_pk_bf16(v0[0], v0[1]); w0.y = cvt_pk_bf16(v0[2], v0[3]); w1.x = cvt_pk_bf16(v1[0], v1[1]); w1.y = cvt_pk_bf16(v1[2], v1[3]);
                        *(u32x2*)(Qb + (size_t)row * 384 + c0) = w0; *(u32x2*)(Qb + (size_t)row * 384 + c0 + 16) = w1;
                    } else if (cb < 640) {
                        const int kc = c0 - 384, kc1 = kc + 16;
                        u32x2 w0, w1; w0.x = cvt_pk_bf16(v0[0], v0[1]); w0.y = cvt_pk_bf16(v0[2], v0[3]); w1.x = cvt_pk_bf16(v1[0], v1[1]); w1.y = cvt_pk_bf16(v1[2], v1[3]);
                        *(u32x2*)(Kb + kt_off(row, kc >> 6, kc & 63)) = w0; *(u32x2*)(Kb + kt_off(row, kc1 >> 6, kc1 & 63)) = w1;
                    } else {
                        u32x2 w0, w1; w0.x = cvt_pk_bf16(v0[0], v0[1]); w0.y = cvt_pk_bf16(v0[2], v0[3]); w1.x = cvt_pk_bf16(v1[0], v1[1]); w1.y = cvt_pk_bf16(v1[2], v1[3]);
                        { const int vc = c0 - 640; *(u32x2*)(Vb + vt_off(row, vc >> 6, vc & 63)) = w0; *(u32x2*)(Vb + vt_off(row, (vc + 16) >> 6, (vc + 16) & 63)) = w1; }
                    }
                    asm volatile("" ::: "memory"); }
            }
        }
    }
};
struct EpiBranch {
    static constexpr bool PERM = true, AFTER_DRAIN = false, KEEP_ACC = true, HAS_INIT = false, HAS_PRE = false;
    const bf16_t* Z; bf16_t* mg;
    __device__ __forceinline__ bool keep(const Unit& u) const { return u.sub != 3; }
    __device__ __forceinline__ void operator()(f32x4 (&acc)[2][2][4][2], const Unit& u, int wr, int wc, int fr, int fq) const {
        asm volatile("" : "+v"(fr), "+v"(fq));
        const int row0 = u.pm * BM + wr * 64 + fr, col0 = u.pn * BM + wc * 32 + 8 * fq, sub = u.sub;
        const bool ratio = sub != 3; const int nofs = ratio ? DM : 0;
        const bf16_t* gbase = Z + (size_t)row0 * INP + ZC_GATE + sub * DM + col0;
        constexpr int GRP = 4;
#pragma unroll
        for (int g0 = 0; g0 < 16; g0 += GRP) { u32x4 gw[GRP], gn[GRP];
#pragma unroll
            for (int k = 0; k < GRP; ++k) { const int p_ = g0 + k, ai = p_ >> 3, m = (p_ >> 1) & 3, bj = p_ & 1; const bf16_t* gp = gbase + (size_t)(ai * HALF + m * 16) * INP + bj * HALF; gw[k] = *(const u32x4*)gp; gn[k] = *(const u32x4*)(gp + nofs); }
            static_assert(GRP == 4, "pin list"); asm volatile("" : "+v"(gw[0]), "+v"(gw[1]), "+v"(gw[2]), "+v"(gw[3]), "+v"(gn[0]), "+v"(gn[1]), "+v"(gn[2]), "+v"(gn[3]));
#pragma unroll
            for (int k = 0; k < GRP; ++k) { const int p_ = g0 + k, ai = p_ >> 3, m = (p_ >> 1) & 3, bj = p_ & 1;
                f32x4 s0 = (f32x4){bf_lo(gw[k].x), bf_hi(gw[k].x), bf_lo(gw[k].y), bf_hi(gw[k].y)}, s1 = (f32x4){bf_lo(gw[k].z), bf_hi(gw[k].z), bf_lo(gw[k].w), bf_hi(gw[k].w)};
                const f32x4 r0 = (f32x4){__builtin_amdgcn_rcpf(bf_lo(gn[k].x)), __builtin_amdgcn_rcpf(bf_hi(gn[k].x)), __builtin_amdgcn_rcpf(bf_lo(gn[k].y)), __builtin_amdgcn_rcpf(bf_hi(gn[k].y))};
                const f32x4 r1 = (f32x4){__builtin_amdgcn_rcpf(bf_lo(gn[k].z)), __builtin_amdgcn_rcpf(bf_hi(gn[k].z)), __builtin_amdgcn_rcpf(bf_lo(gn[k].w)), __builtin_amdgcn_rcpf(bf_hi(gn[k].w))};
#pragma unroll
                for (int e = 0; e < 4; ++e) { s0[e] *= ratio ? r0[e] : 1.0f; s1[e] *= ratio ? r1[e] : 1.0f; }
                acc[ai][bj][m][0] *= s0; acc[ai][bj][m][1] *= s1; }
            asm volatile("" ::: "memory"); }
        if (!ratio) {
#pragma unroll
            for (int ai = 0; ai < 2; ++ai)
#pragma unroll
                for (int m = 0; m < 4; ++m) { const int row = row0 + ai * HALF + m * 16;
#pragma unroll
                    for (int bj = 0; bj < 2; ++bj) { const f32x4 v0 = acc[ai][bj][m][0], v1 = acc[ai][bj][m][1];
                        u32x4 w; w.x = cvt_pk_bf16(v0[0], v0[1]); w.y = cvt_pk_bf16(v0[2], v0[3]); w.z = cvt_pk_bf16(v1[0], v1[1]); w.w = cvt_pk_bf16(v1[2], v1[3]);
                        *(u32x4*)(mg + (size_t)row * DM + col0 + bj * HALF) = w; } }
        }
    }
};

struct NoHook { static constexpr bool ON = false; __device__ __forceinline__ void operator()() const {} };
template <class Epi, class Sched, bool ALIGN_EPI = false, bool SP2 = false, class Hook = NoHook>
__device__ __forceinline__ void gemm_phase(PG8_LAS unsigned char* lds, const Gemm g, const Sched& S, const Epi& E, const Hook& hook = Hook()) {
    static_assert(!Hook::ON || SP2, "the hook variant is written for the SP2 prologue");
    int tid_ = threadIdx.x; asm volatile("" : "+v"(tid_));
    const int tid = tid_, wid = __builtin_amdgcn_readfirstlane(tid >> 6), lane = tid & 63, wr = wid >> 2, wc = wid & 3, fr = lane & 15, fq = lane >> 4;
    const int K = g.K, nt = K / BK, lda = g.lda, ldb = g.ldb;
    unsigned voffA[2], voffB[2];
#pragma unroll
    for (int i = 0; i < 2; ++i) { int R, C; stage_rc(tid * 16 + i * 8192, R, C); const int Rb = Epi::PERM ? ((R & ~31) + perm32(R & 31)) : R;
        voffA[i] = (unsigned)(R * lda + C) * 2u; voffB[i] = (unsigned)(Rb * ldb + C) * 2u; }
    const size_t kstep = (size_t)(BK * 2);
    const size_t hstepA = (size_t)HALF * lda * 2, hstepB = (size_t)HALF * ldb * 2;
    const unsigned ldsw = (unsigned)wid * 1024u;
    const int aoff = lds_byte(wr * 64 + fr, fq * 8), boff = lds_byte(wc * 32 + fr, fq * 8);
#define PG8_SA(b, h) (((b) * 2 + (h)) * HTB)
#define PG8_SB(b, h) ((4 + (b) * 2 + (h)) * HTB)
#define PG8_STAGE(bufoff, gbase, voff) do { _Pragma("unroll") for (int _i = 0; _i < 2; ++_i) \
        __builtin_amdgcn_global_load_lds((const unsigned*)((const char*)(gbase) + (voff)[_i]), (PG8_LAS unsigned*)(lds + (bufoff) + ldsw + _i * 8192), 16, 0, 0); } while (0)
#define PG8_LDA(dst, b, h) do { _Pragma("unroll") for (int m = 0; m < 4; ++m) _Pragma("unroll") for (int k = 0; k < 2; ++k) dst[m][k] = *(const PG8_LAS bf16x8*)(lds + PG8_SA(b, h) + aoff + m * 2048 + k * 1024); } while (0)
#define PG8_LDB(dst, b, h) do { _Pragma("unroll") for (int n = 0; n < 2; ++n) _Pragma("unroll") for (int k = 0; k < 2; ++k) dst[n][k] = *(const PG8_LAS bf16x8*)(lds + PG8_SB(b, h) + boff + n * 2048 + k * 1024); } while (0)
#define PG8_MMA(ai, bj, At, Bt) do { __builtin_amdgcn_s_setprio(1); _Pragma("unroll") for (int m = 0; m < 4; ++m) _Pragma("unroll") for (int n = 0; n < 2; ++n) _Pragma("unroll") for (int k = 0; k < 2; ++k) \
        acc[ai][bj][m][n] = __builtin_amdgcn_mfma_f32_16x16x32_bf16(Bt[n][k], At[m][k], acc[ai][bj][m][n], 0, 0, 0); __builtin_amdgcn_s_setprio(0); } while (0)
#define PG8_WAIT_V(n) asm volatile("s_waitcnt vmcnt(" #n ")" ::: "memory")
#define PG8_WAIT_L(n) asm volatile("s_waitcnt lgkmcnt(" #n ")" ::: "memory")
#define PG8_BAR __builtin_amdgcn_s_barrier()
#define PG8_SCHED __builtin_amdgcn_sched_barrier(0)
    Unit cur, nxt; int ui = 0;
    if (!S.next(0, cur)) { if constexpr (Hook::ON) hook(); return; }
    if constexpr (Hook::ON) {
        const char* hA = S.a_ptr(cur); const char* hB = S.b_ptr(cur); S.a_ready(cur);
        PG8_STAGE(PG8_SB(0, 0), hB, voffB); PG8_STAGE(PG8_SB(0, 1), hB + hstepB, voffB); PG8_STAGE(PG8_SA(0, 0), hA, voffA); PG8_STAGE(PG8_SA(0, 1), hA + hstepA, voffA);
        hook();
    }
    f32x4 acc[2][2][4][2];
#pragma unroll
    for (int a = 0; a < 2; ++a)
#pragma unroll
        for (int b = 0; b < 2; ++b)
#pragma unroll
            for (int m = 0; m < 4; ++m)
#pragma unroll
                for (int n = 0; n < 2; ++n) acc[a][b][m][n] = (f32x4){0.f, 0.f, 0.f, 0.f};
    if constexpr (Epi::HAS_INIT) E.init(acc, cur, wr, wc, fr, fq);
    f32x4 pq0[2]; if constexpr (Epi::HAS_PRE) E.pre_load(cur, wr, wc, fr, fq, pq0);
    bf16x8 At[4][2], B0[2][2], B1[2][2];
    const char* cA = S.a_ptr(cur); const char* cB = S.b_ptr(cur);
    if constexpr (!Hook::ON) S.a_ready(cur);
    if constexpr (SP2) {
        if constexpr (!Hook::ON) { PG8_STAGE(PG8_SB(0, 0), cB, voffB); PG8_STAGE(PG8_SB(0, 1), cB + hstepB, voffB); PG8_STAGE(PG8_SA(0, 0), cA, voffA); PG8_STAGE(PG8_SA(0, 1), cA + hstepA, voffA); }
        if (wr == 1) PG8_BAR;
        PG8_WAIT_V(2); PG8_BAR;
        PG8_STAGE(PG8_SB(1, 0), cB + kstep, voffB); PG8_STAGE(PG8_SA(1, 0), cA + kstep, voffA); PG8_STAGE(PG8_SB(1, 1), cB + hstepB + kstep, voffB);
        PG8_WAIT_V(6); PG8_BAR;
    } else {
        PG8_STAGE(PG8_SB(0, 0), cB, voffB); PG8_STAGE(PG8_SA(0, 0), cA, voffA); PG8_STAGE(PG8_SB(0, 1), cB + hstepB, voffB); PG8_STAGE(PG8_SA(0, 1), cA + hstepA, voffA);
        if (wr == 1) PG8_BAR;
        PG8_WAIT_V(4); PG8_BAR;
        PG8_STAGE(PG8_SB(1, 0), cB + kstep, voffB); PG8_STAGE(PG8_SA(1, 0), cA + kstep, voffA); PG8_STAGE(PG8_SB(1, 1), cB + hstepB + kstep, voffB);
        PG8_WAIT_V(6); PG8_BAR;
    }
    if constexpr (Epi::HAS_PRE) E.pre_commit(pq0, wr, wc, fr, fq, 0);
    for (;;) {
        const bool has_next = S.next(ui + 1, nxt);
        const char* nA = has_next ? S.a_ptr(nxt) : cA; const char* nB = has_next ? S.b_ptr(nxt) : cB;
#pragma unroll 1
        for (int t = 0; t < nt; t += 2) {
            const bool last = (t == nt - 2);
            const char* a1 = cA + (size_t)(t + 1) * kstep;
            const char* a2 = last ? nA : cA + (size_t)(t + 2) * kstep; const char* b2 = last ? nB : cB + (size_t)(t + 2) * kstep;
            const char* a3 = a2 + kstep; const char* b3 = b2 + kstep;
            if (last && has_next) S.a_ready(nxt);
            if constexpr (SP2) {
            PG8_LDB(B0, 0, 0); PG8_LDB(B1, 0, 1); PG8_SCHED; PG8_LDA(At, 0, 0); PG8_STAGE(PG8_SA(1, 1), a1 + hstepA, voffA);
            PG8_WAIT_V(8); PG8_WAIT_L(0); PG8_BAR; PG8_MMA(0, 0, At, B0); PG8_MMA(0, 1, At, B1); PG8_BAR; PG8_SCHED;
            PG8_LDA(At, 0, 1); PG8_STAGE(PG8_SB(0, 0), b2, voffB); PG8_STAGE(PG8_SB(0, 1), b2 + hstepB, voffB); PG8_STAGE(PG8_SA(0, 0), a2, voffA);
            PG8_WAIT_V(8); PG8_WAIT_L(0); PG8_BAR; PG8_MMA(1, 0, At, B0); PG8_MMA(1, 1, At, B1); PG8_BAR; PG8_SCHED;
            PG8_LDB(B0, 1, 0); PG8_LDB(B1, 1, 1); PG8_SCHED; PG8_LDA(At, 1, 0); PG8_STAGE(PG8_SA(0, 1), a2 + hstepA, voffA);
            PG8_WAIT_V(8); PG8_WAIT_L(0); PG8_BAR; PG8_MMA(0, 0, At, B0); PG8_MMA(0, 1, At, B1); PG8_BAR; PG8_SCHED;
            PG8_LDA(At, 1, 1); PG8_STAGE(PG8_SB(1, 0), b3, voffB); PG8_STAGE(PG8_SB(1, 1), b3 + hstepB, voffB); PG8_STAGE(PG8_SA(1, 0), a3, voffA);
            PG8_WAIT_V(8); PG8_WAIT_L(0); PG8_BAR; PG8_MMA(1, 0, At, B0); PG8_MMA(1, 1, At, B1); PG8_BAR; PG8_SCHED;
            } else {
            PG8_LDB(B0, 0, 0); PG8_SCHED; PG8_LDA(At, 0, 0); PG8_STAGE(PG8_SA(1, 1), a1 + hstepA, voffA);
            PG8_WAIT_L(8); PG8_BAR; PG8_WAIT_L(0); PG8_MMA(0, 0, At, B0); PG8_BAR; PG8_SCHED;
            PG8_LDB(B1, 0, 1); PG8_STAGE(PG8_SB(0, 0), b2, voffB);
            PG8_BAR; PG8_WAIT_L(0); PG8_MMA(0, 1, At, B1); PG8_BAR;
            PG8_LDA(At, 0, 1); PG8_STAGE(PG8_SA(0, 0), a2, voffA);
            PG8_BAR; PG8_WAIT_L(0); PG8_MMA(1, 0, At, B0); PG8_BAR; PG8_SCHED;
            PG8_STAGE(PG8_SB(0, 1), b2 + hstepB, voffB);
            PG8_WAIT_V(6); PG8_BAR; PG8_MMA(1, 1, At, B1); PG8_BAR;
            PG8_LDB(B0, 1, 0); PG8_SCHED; PG8_LDA(At, 1, 0); PG8_STAGE(PG8_SA(0, 1), a2 + hstepA, voffA);
            PG8_WAIT_L(8); PG8_BAR; PG8_WAIT_L(0); PG8_MMA(0, 0, At, B0); PG8_BAR; PG8_SCHED;
            PG8_LDB(B1, 1, 1); PG8_STAGE(PG8_SB(1, 0), b3, voffB);
            PG8_BAR; PG8_WAIT_L(0); PG8_MMA(0, 1, At, B1); PG8_BAR;
            PG8_LDA(At, 1, 1); PG8_STAGE(PG8_SA(1, 0), a3, voffA);
            PG8_BAR; PG8_WAIT_L(0); PG8_MMA(1, 0, At, B0); PG8_BAR; PG8_SCHED;
            PG8_STAGE(PG8_SB(1, 1), b3 + hstepB, voffB);
            PG8_WAIT_V(6); PG8_BAR; PG8_MMA(1, 1, At, B1); PG8_BAR;
            }
        }
        if constexpr (ALIGN_EPI) { if (wr == 0) PG8_BAR; }
        f32x4 pq[2];
        if constexpr (Epi::HAS_PRE) { if (has_next) E.pre_load(nxt, wr, wc, fr, fq, pq); }
        if constexpr (!Epi::AFTER_DRAIN) { if constexpr (Epi::HAS_PRE) E(acc, cur, wr, wc, fr, fq, ui & 1); else E(acc, cur, wr, wc, fr, fq); S.done(cur); }
        if constexpr (Epi::HAS_PRE) { if (has_next) E.pre_commit(pq, wr, wc, fr, fq, (ui + 1) & 1); }
        if (!has_next) break;
        if (!(Epi::KEEP_ACC && E.keep(cur))) {
#pragma unroll
        for (int a = 0; a < 2; ++a)
#pragma unroll
            for (int b = 0; b < 2; ++b)
#pragma unroll
                for (int m = 0; m < 4; ++m)
#pragma unroll
                    for (int n = 0; n < 2; ++n) acc[a][b][m][n] = (f32x4){0.f, 0.f, 0.f, 0.f};
        if constexpr (Epi::HAS_INIT) E.init(acc, nxt, wr, wc, fr, fq);
        }
        cur = nxt; cA = nA; cB = nB; ++ui;
        if constexpr (ALIGN_EPI) { if (wr == 1) PG8_BAR; }
    }
    PG8_WAIT_V(0);
    if constexpr (!ALIGN_EPI) { if (wr == 0) PG8_BAR; }
    PG8_BAR;
    if constexpr (Epi::AFTER_DRAIN) { E.fused(acc, cur, wr, wc, fr, fq, lds, wid, lane); S.done(cur); }
#undef PG8_SA
#undef PG8_SB
#undef PG8_STAGE
#undef PG8_LDA
#undef PG8_LDB
#undef PG8_MMA
#undef PG8_WAIT_V
#undef PG8_WAIT_L
#undef PG8_BAR
#undef PG8_SCHED
}
}

typedef unsigned short bf16;
typedef unsigned v4u __attribute__((ext_vector_type(4)));
typedef unsigned v2u __attribute__((ext_vector_type(2)));
typedef float f32x4 __attribute__((ext_vector_type(4)));
typedef float f32x2 __attribute__((ext_vector_type(2)));
typedef short bf16x8 __attribute__((ext_vector_type(8)));
typedef GAS unsigned gu32;
typedef GAS unsigned long long gu64;
#define RLX_AGENT __ATOMIC_RELAXED, __HIP_MEMORY_SCOPE_AGENT
#define LDS_WAIT() asm volatile("s_waitcnt lgkmcnt(0)" ::: "memory")
#define VM_WAIT() asm volatile("s_waitcnt vmcnt(0)" ::: "memory")
__device__ __forceinline__ unsigned f2bf(float f) { unsigned u = __builtin_bit_cast(unsigned, f); return (u + 0x7fffu + ((u >> 16) & 1u)) >> 16; }
__device__ __forceinline__ unsigned pk2(float lo, float hi) { return f2bf(lo) | (f2bf(hi) << 16); }
__device__ __forceinline__ float bflo(unsigned w) { return __uint_as_float(w << 16); }
__device__ __forceinline__ float bfhi(unsigned w) { return __uint_as_float(w & 0xffff0000u); }
__device__ __forceinline__ float gelu_tanh(float x) {
    const float inner = 0.7978845608028654f * (x + 0.044715f * x * x * x);
    return x * __builtin_amdgcn_rcpf(1.f + __builtin_amdgcn_exp2f(-2.f * 1.4426950408889634f * inner));
}
__device__ __forceinline__ float silu1(float x) { return x * __builtin_amdgcn_rcpf(1.f + __builtin_amdgcn_exp2f(-1.4426950408889634f * x)); }
__device__ __forceinline__ float sigm1(float x) { return __builtin_amdgcn_rcpf(1.f + __builtin_amdgcn_exp2f(-1.4426950408889634f * x)); }
__device__ __forceinline__ float wave_sum(float v) {
    return xadd32(xadd16(xadd8(xadd4(xadd2(xadd1(v))))));
}

#define XB_TMO      128
#define XB_XCNT(j)  (256  + 64 * (j))
#define XB_XSUB(j)  (1280 + 64 * (j))
#define XB_XGEN(j)  (2304 + 64 * (j))
#define XB_TOP      3328
#define XB_TOPGEN   3392
#define XCD_BAR_WORDS 3456
#define XB_SPIN_CAP (1u << 18)

__device__ __forceinline__ unsigned xb_ld(unsigned* p)              { return __hip_atomic_load(p, __ATOMIC_RELAXED, __HIP_MEMORY_SCOPE_AGENT); }
__device__ __forceinline__ unsigned xb_add(unsigned* p, unsigned v) { return __hip_atomic_fetch_add(p, v, __ATOMIC_RELAXED, __HIP_MEMORY_SCOPE_AGENT); }
__device__ __forceinline__ unsigned xb_xcc_id() { return (unsigned)__builtin_amdgcn_s_getreg((3 << 11) | 20) & 0xFu; }
#define XB_SPIN(cond, bar) do { unsigned _sp = 0; while (cond) { __builtin_amdgcn_s_sleep(1); \
    if ((++_sp & 255u) == 0u) { if (xb_ld(&(bar)[XB_TMO])) break; if (_sp > XB_SPIN_CAP) { atomicAdd(&(bar)[XB_TMO], 1u); break; } } } } while (0)

struct XcdBarrier {
    unsigned* bar; unsigned x;
    volatile LAS unsigned* st;
};

__device__ __forceinline__ XcdBarrier xcd_barrier_post(unsigned* bar, volatile LAS unsigned* st) {
    XcdBarrier b; b.bar = bar; b.x = xb_xcc_id(); b.st = st;
    if (threadIdx.x == 0) (void)xb_add(&bar[XB_XCNT(b.x)], 1u);
    return b;
}
__device__ __forceinline__ void xcd_barrier_complete(unsigned* bar, unsigned x, unsigned& nloc, unsigned& nx) {
    const unsigned G = gridDim.x * gridDim.y * gridDim.z;
    unsigned sum, cnt, mine, sp = 0u;
    for (;;) {
        sum = 0u; cnt = 0u; mine = 0u;
#pragma unroll
        for (unsigned j = 0; j < 16; ++j) { const unsigned c = xb_ld(&bar[XB_XCNT(j)]); sum += c; cnt += (c > 0u) ? 1u : 0u; mine = (j == x) ? c : mine; }
        if (sum == G) break;
        __builtin_amdgcn_s_sleep(1);
        if ((++sp & 255u) == 0u) { if (xb_ld(&bar[XB_TMO])) break; if (sp > XB_SPIN_CAP) { atomicAdd(&bar[XB_TMO], 1u); break; } }
    }
    nloc = mine > 0u ? mine : 1u; nx = cnt > 0u ? cnt : 1u;
}

__device__ __forceinline__ void xcd_barrier(const XcdBarrier& b) {
    asm volatile("s_waitcnt vmcnt(0)" ::: "memory");
    __syncthreads();
    if (threadIdx.x == 0) {
        unsigned* bar = b.bar;
        __builtin_amdgcn_s_waitcnt(0);
        unsigned nloc = b.st[0], nx = b.st[1];
        if (nloc == 0u) { xcd_barrier_complete(bar, b.x, nloc, nx); b.st[0] = nloc; b.st[1] = nx; }
        const unsigned old = xb_add(&bar[XB_XSUB(b.x)], 1u);
        const unsigned gen = old / nloc;
        if (old + 1u == (gen + 1u) * nloc) {
            __builtin_amdgcn_fence(__ATOMIC_RELEASE, "agent");
            asm volatile("s_waitcnt vmcnt(0)" ::: "memory");
            const unsigned og = xb_add(&bar[XB_TOP], 1u);
            const unsigned tg = og / nx;
            if (og + 1u == (tg + 1u) * nx) xb_add(&bar[XB_TOPGEN], 1u);
            else XB_SPIN(xb_ld(&bar[XB_TOPGEN]) == tg, bar);
            __builtin_amdgcn_fence(__ATOMIC_ACQUIRE, "agent");
            xb_add(&bar[XB_XGEN(b.x)], 1u);
            asm volatile("s_waitcnt vmcnt(0)" ::: "memory");
        } else {
            XB_SPIN(xb_ld(&bar[XB_XGEN(b.x)]) == gen, bar);
            __builtin_amdgcn_fence(__ATOMIC_ACQUIRE, "agent");
            asm volatile("s_waitcnt vmcnt(0)" ::: "memory");
        }
    }
    __syncthreads();
}


struct Frame {
    LAS unsigned char* lds;
    volatile LAS unsigned* MISC;
    gu32* ctl;
    int tid, lane, wave;
    int vcu, G, bid;
    unsigned char* ws; float* out;
};

__device__ __forceinline__ void tr_item_wg(const float* W, int ldw, int k0, int n0, int nmax, bf16* dst, int dst_ld, int mode, int row_off, int dst_col0, const float* gain, LAS unsigned char* scr, int tid) {
    const int wave = tid >> 6, lane = tid & 63; const int n = n0 + 4 * lane; const bool ok = n < nmax;
    const float* src = W + (size_t)(k0 + 8 * wave) * ldw + (ok ? n : n0);
    f32x4 v[8];
#pragma unroll
    for (int j = 0; j < 8; ++j) v[j] = *(const f32x4*)(src + (size_t)j * ldw);
    asm volatile("" : "+v"(v[0]), "+v"(v[1]), "+v"(v[2]), "+v"(v[3]), "+v"(v[4]), "+v"(v[5]), "+v"(v[6]), "+v"(v[7]));
    if (gain) {
#pragma unroll
        for (int j = 0; j < 8; ++j) v[j] = v[j] * gain[k0 + 8 * wave + j]; }
#pragma unroll
    for (int e = 0; e < 4; ++e) { v2u a, b; a.x = pk2(v[0][e], v[1][e]); a.y = pk2(v[2][e], v[3][e]); b.x = pk2(v[4][e], v[5][e]); b.y = pk2(v[6][e], v[7][e]);
        LAS unsigned char* p = scr + (4 * lane + e) * 136 + 16 * wave; *(LAS v2u*)p = a; *(LAS v2u*)(p + 8) = b; }
    __syncthreads();
#pragma unroll
    for (int i = 0; i < 4; ++i) { const int q = tid + 512 * i, row = q >> 3, c = q & 7; const LAS unsigned char* p = scr + row * 136 + 16 * c;
        const v2u a = *(const LAS v2u*)p, b = *(const LAS v2u*)(p + 8); const int nn = n0 + row;
        if (nn < nmax) { const int drow = mode ? ((nn >> 7) * 256 + row_off + (nn & 127)) : (row_off + nn); v4u o; o.x = a.x; o.y = a.y; o.z = b.x; o.w = b.y;
            *(GAS v4u*)(dst + (size_t)drow * dst_ld + dst_col0 + 8 * c) = o; } }
    __syncthreads();
}
struct InRaw { const float* p[33]; };
struct InPtrs { const LAS unsigned long long* tab;
    __device__ __forceinline__ const float* p(int i) const { const unsigned long long v = tab[i]; const unsigned lo = __builtin_amdgcn_readfirstlane((unsigned)v), hi = __builtin_amdgcn_readfirstlane((unsigned)(v >> 32));
        return (const float*)(const GAS float*)(((unsigned long long)hi << 32) | lo); } };

__host__ __device__ constexpr int conv_seg_items(int seg) { return seg == 6 ? 400 : (seg == 7 || seg == 8) ? 64 : seg == 9 ? 12 : 176; }
__device__ __forceinline__ void conv_item(Frame& F, const InPtrs& I, int L, int seg, int it, LAS unsigned char* scr, int tid) {
    unsigned char* wl = F.ws + WS_WL + (size_t)L * WL_STRIDE;
    if (seg <= 5) { const int f = seg >= 3, s = seg - 3 * f;
        if (s < 2) { constexpr int NB = DFF / 256; const int kb = it / NB, nb = it % NB;
            tr_item_wg(I.p(f ? (s ? 30 : 29) : (s ? 9 : 8)) + (size_t)L * DM * DFF, DFF, kb * 64, nb * 256, DFF, (bf16*)(wl + (f ? WL_GU2 : WL_GU1)), DM, 1, s * 128, kb * 64, I.p(f ? 28 : 7) + L * DM, scr, tid); }
        else { constexpr int NBD = DM / 256; const int kb = it / NBD, nb = it % NBD;
            tr_item_wg(I.p(f ? 31 : 10) + (size_t)L * DFF * DM, DM, kb * 64, nb * 256, DM, (bf16*)(wl + (f ? WL_D2 : WL_D1)), DFF, 0, 0, kb * 64, nullptr, scr, tid); } }
    else if (seg == 6) { constexpr int NB = (INC + 255) / 256; const int kb = it / NB, nb = it % NB;
        tr_item_wg(I.p(12) + (size_t)L * DM * INC, INC, kb * 64, nb * 256, INC, (bf16*)(wl + WL_IN), DM, 0, 0, kb * 64, I.p(11) + L * DM, scr, tid); }
    else if (seg == 7) { constexpr int NB = DM / 256, NI1 = (BRW / 64) * NB; const int i = it / NI1, r = it % NI1, kb = r / NB, nb = r % NB;
        tr_item_wg(I.p(26) + ((size_t)L * 4 + i) * BRW * DM, DM, kb * 64, nb * 256, DM, (bf16*)(wl + WL_BR) + (size_t)i * DM * BRW, BRW, 0, 0, kb * 64, nullptr, scr, tid); }
    else if (seg == 8) { constexpr int NB = DM / 256; const int kb = it / NB, nb = it % NB;
        tr_item_wg(I.p(27) + (size_t)L * DM * DM, DM, kb * 64, nb * 256, DM, (bf16*)(wl + WL_O), DM, 0, 0, kb * 64, nullptr, scr, tid); }
    else { bf16* Wc = (bf16*)(F.ws + WS_WCAT + (size_t)L * WCAT_BYTES); constexpr int NIQ = (256 / 64) * 2, NIK = 128 / 64;
        if (it < NIQ) { const int kb = it / 2, nb = it % 2; tr_item_wg(I.p(19) + (size_t)L * 256 * 384, 384, kb * 64, nb * 256, 384, Wc, 384, 0, 0, kb * 64, I.p(17) + L * 256, scr, tid); }
        else { const int r = it - NIQ, which = r >= NIK, kb = which ? r - NIK : r;
            tr_item_wg(I.p(which ? 21 : 20) + (size_t)L * 128 * 256, 256, kb * 64, 0, 256, Wc, 384, 0, which ? 640 : 384, 256 + kb * 64, nullptr, scr, tid); } }
}
struct ConvJob { int n; unsigned char js[8]; };
__host__ __device__ constexpr ConvJob conv_jobs(int list) {
    return list == 0 ? ConvJob{2, {0x00, 0x01}}
         : list == 1 ? ConvJob{2, {0x02, 0x06}}
         : list == 2 ? ConvJob{5, {0x09, 0x07, 0x08, 0x03, 0x04}}
         : list == 3 ? ConvJob{3, {0x05, 0x10, 0x11}}
         : list == 4 ? ConvJob{2, {0x12, 0x16}}
         :             ConvJob{6, {0x19, 0x17, 0x18, 0x13, 0x14, 0x15}};
}
template <int LIST> __device__ __forceinline__ void conv_list_item(Frame& F, const InPtrs& I, int it, LAS unsigned char* scr, int tid, bool& done) {
    constexpr ConvJob J = conv_jobs(LIST); int base = 0; done = true;
#pragma unroll
    for (int k = 0; k < J.n; ++k) { const int cnt = conv_seg_items(J.js[k] & 15);
        if (it >= base && it < base + cnt) { conv_item(F, I, J.js[k] >> 4, J.js[k] & 15, it - base, scr, tid); done = false; }
        base += cnt; }
}
template <int LIST> __device__ __forceinline__ void conv_drain_queue(Frame& F, const InPtrs& I, gu32* qh) {
    LAS unsigned char* scr = F.lds + RING_OFF;
    __syncthreads(); if (F.tid == 0) F.MISC[1] = __hip_atomic_fetch_add(qh, 1u, RLX_AGENT); __syncthreads();
    int it = (int)F.MISC[1];
    for (;;) { unsigned nx = 0u; if (F.tid == 0) nx = __hip_atomic_fetch_add(qh, 1u, RLX_AGENT);
        bool done; conv_list_item<LIST>(F, I, it, scr, F.tid, done); if (done) break;
        if (F.tid == 0) F.MISC[1] = nx; __syncthreads(); it = (int)F.MISC[1]; }
}
#ifndef PROSKIP
#define PROSKIP 0
#endif
__device__ __forceinline__ void p0_prologue(Frame& F, const InPtrs& I, const bool ex = false) {
    const int gw = F.vcu * NWAVES + F.wave, NGW = F.G * NWAVES, lane = F.lane, tid = F.tid;
    LAS unsigned char* scr = F.lds + RING_OFF;
    if (!(ex && (PROSKIP & 1))) { constexpr int NIT = 2 * 176;
        for (int it = F.vcu; it < NIT; it += F.G) { bool d; conv_list_item<0>(F, I, it, scr, tid, d); } }
    for (int L = 0; L < 2; ++L) {
        {
            const float* W = I.p(15) + (size_t)L * 4 * 128 * 128; bf16* Wt = (bf16*)(F.ws + WS_WSB) + (size_t)L * 4 * 128 * 128;
            for (int e = (gw * 64 + lane) * 4; e < 4 * 128 * 128; e += NGW * 64 * 4) { const f32x4 v = *(const f32x4*)(W + e); const int i = (e >> 7) & 127, j = e & 127;
                v2u o; o.x = pk2(j <= i ? v[0] : 0.f, j + 1 <= i ? v[1] : 0.f); o.y = pk2(j + 2 <= i ? v[2] : 0.f, j + 3 <= i ? v[3] : 0.f); *(v2u*)(Wt + e) = o; }
        }
    }
    if (!(ex && (PROSKIP & 2))) {
        float* tab = (float*)(F.ws + WS_ROPE);
        for (int e = gw * 64 + lane; e < (SEQ + TS) * 16; e += NGW * 64) { const int pos = e >> 4, i = e & 15;
            const float inv = powf(10000.0f, -(float)i / 16.0f); const float ang = (float)pos * inv; tab[pos * 32 + i] = cosf(ang); tab[pos * 32 + 16 + i] = sinf(ang); }
    }
    if (!(ex && (PROSKIP & 4))) {
        bf16* hb = (bf16*)(F.ws + WS_HB); float* ssq = (float*)(F.ws + WS_SSQ);
        const float* xa = I.p(0); const float* xb = I.p(1);
        f32x4 cur[4], nxt[4];
        if (gw < MROWS) { const GAS f32x4* xp = (const GAS f32x4*)(gw < NPR ? xa + (size_t)gw * DM : xb + (size_t)(gw - NPR) * DM) + lane;
#pragma unroll
            for (int j = 0; j < 4; ++j) cur[j] = xp[64 * j]; }
        for (int m = gw; m < MROWS; m += NGW) { const int m2 = m + NGW;
            if (m2 < MROWS) { const GAS f32x4* xp = (const GAS f32x4*)(m2 < NPR ? xa + (size_t)m2 * DM : xb + (size_t)(m2 - NPR) * DM) + lane;
#pragma unroll
                for (int j = 0; j < 4; ++j) nxt[j] = xp[64 * j]; }
            GAS v2u* hp = (GAS v2u*)(hb + (size_t)m * DM) + lane; float s = 0.f;
#pragma unroll
            for (int j = 0; j < 4; ++j) { const f32x4 v = cur[j]; s += (v.x * v.x + v.y * v.y) + (v.z * v.z + v.w * v.w); v2u o; o.x = pk2(v.x, v.y); o.y = pk2(v.z, v.w); hp[64 * j] = o; }
            s = wave_sum(s); if (lane < 16) ssq[(size_t)m * 16 + lane] = lane == 0 ? s : 0.f;
#pragma unroll
            for (int j = 0; j < 4; ++j) cur[j] = nxt[j]; }
    }
}

__device__ __forceinline__ f32x4 ld4bf(const bf16* p) { const v2u w = *(const v2u*)p; return (f32x4){bflo(w.x), bfhi(w.x), bflo(w.y), bfhi(w.y)}; }
__device__ __forceinline__ void st4bf(bf16* p, f32x4 v) { v2u o; o.x = pk2(v[0], v[1]); o.y = pk2(v[2], v[3]); *(v2u*)p = o; }
__device__ __forceinline__ f32x4 glu4(const bf16* Zr, int c) { const f32x4 a = ld4bf(Zr + ZC_DV + c), g = ld4bf(Zr + ZC_DG + c); return (f32x4){a[0] * sigm1(g[0]), a[1] * sigm1(g[1]), a[2] * sigm1(g[2]), a[3] * sigm1(g[3])}; }

__device__ __forceinline__ void p_prep(Frame& F, const InPtrs& I, int L) {
    const bf16* Z = (const bf16*)(F.ws + WS_Z); bf16* YS = (bf16*)(F.ws + WS_YS); bf16* QL = (bf16*)(F.ws + WS_QL); bf16* KB = (bf16*)(F.ws + WS_KB);
    float* out = F.out; const float* rope = (const float*)(F.ws + WS_ROPE);
    const int gw = F.vcu * NWAVES + F.wave, NGW = F.G * NWAVES, lane = F.lane, wave = F.wave;
    {
        const float* kvg = I.p(18) + L * KVR; const float* scw = I.p(13) + L * 3 * BRW; const float* sta = I.p(5) + (size_t)L * NSEQ_S * 2 * BRW;
        const int c = 4 * lane;
        const f32x4 w0 = *(const f32x4*)(scw + c), w1 = *(const f32x4*)(scw + BRW + c), w2 = *(const f32x4*)(scw + 2 * BRW + c);
        const f32x2 kg = *(const f32x2*)(kvg + 2 * lane);
        const bool deal = (F.G == 256); const int nit = deal ? (F.vcu >= 128 ? 16 : (F.vcu < 64 ? 1 : 0)) : (MROWS + NGW - 1 - gw) / NGW;
#define PREP_ROW(it_) (deal ? ((F.vcu >= 128 ? (F.vcu - 128) * 16 + (it_) : 2048 + F.vcu) * 8 + wave) : gw + (it_) * NGW)
        struct RowIn { v2u cq, ah0, ac0, ah1, ac1, ah2, ac2, ab; unsigned ckv; unsigned short k1, k2; };
        auto load_row = [&](int r) { RowIn x; const bf16* Zr = Z + (size_t)r * INP; const bool pr = r < NPR; const int t = pr ? (r & (SEQ - 1)) : (r & 3);
            const bf16* Z1 = Zr - (t >= 1 ? INP : 0); const bf16* Z2 = Zr - (t >= 2 ? 2 * INP : 0);
            x.cq = *(const v2u*)(Zr + ZC_CQ + c); x.ckv = *(const unsigned*)(Zr + ZC_CKV + 2 * lane); x.k1 = Zr[ZC_CKR + (lane & 15)]; x.k2 = Zr[ZC_CKR + 16 + (lane & 15)];
            x.ah0 = *(const v2u*)(Zr + ZC_AH + c); x.ac0 = *(const v2u*)(Zr + ZC_AC + c); x.ah1 = *(const v2u*)(Z1 + ZC_AH + c); x.ac1 = *(const v2u*)(Z1 + ZC_AC + c);
            x.ah2 = *(const v2u*)(Z2 + ZC_AH + c); x.ac2 = *(const v2u*)(Z2 + ZC_AC + c); x.ab = *(const v2u*)(Zr + ZC_AB + c); return x; };
        auto up4 = [](v2u w) { return (f32x4){bflo(w.x), bfhi(w.x), bflo(w.y), bfhi(w.y)}; };
        RowIn cur, nxt; if (nit > 0) cur = load_row(PREP_ROW(0)); nxt = cur; if (nit > 1) nxt = load_row(PREP_ROW(1));
        for (int it = 0; it < nit; ++it) { const int r = PREP_ROW(it);
            RowIn nx2 = nxt; if (it + 2 < nit) nx2 = load_row(PREP_ROW(it + 2));
            const bool pr = r < NPR; const int t = pr ? (r & (SEQ - 1)) : (r & 3); const int rs_ = r - NPR; const int n = rs_ >> 2; const int pos = pr ? t : SEQ + t;
            { const f32x4 x = up4(cur.cq); const float ss = wave_sum((x[0] * x[0] + x[1] * x[1]) + (x[2] * x[2] + x[3] * x[3]));
              const float rs = __builtin_amdgcn_rsqf(ss * (1.0f / 256.0f) + RMS_EPS); st4bf(QL + (size_t)r * 384 + c, x * rs); }
            { const unsigned w = cur.ckv; const float x0 = bflo(w), x1 = bfhi(w); const float ss = wave_sum(x0 * x0 + x1 * x1);
              const float rs = __builtin_amdgcn_rsqf(ss * (1.0f / 128.0f) + RMS_EPS); const float l0 = x0 * rs * kg[0], l1 = x1 * rs * kg[1];
              float* lo = out + (pr ? OFF_LATP + ((size_t)L * NPR + r) * KVR : OFF_LATS + ((size_t)L * NSR + rs_) * KVR) + 2 * lane; *(f32x2*)lo = (f32x2){l0, l1};
              *(unsigned*)(QL + (size_t)r * 384 + 256 + 2 * lane) = pk2(l0, l1); }
            if (lane < 16) { const float x1 = __uint_as_float((unsigned)cur.k1 << 16), x2 = __uint_as_float((unsigned)cur.k2 << 16);
              const float cs = rope[(size_t)pos * 32 + lane], sn = rope[(size_t)pos * 32 + 16 + lane]; const float o1 = x1 * cs - x2 * sn, o2 = x2 * cs + x1 * sn;
              float* ko = out + (pr ? OFF_KRP + ((size_t)L * NPR + r) * QKR : OFF_KRS + ((size_t)L * NSR + rs_) * QKR); ko[lane] = o1; ko[16 + lane] = o2;
              const bf16 b1 = (bf16)f2bf(o1), b2 = (bf16)f2bf(o2);
#pragma unroll
              for (int h = 0; h < NHEAD; ++h) if (pr) { KB[kt_off(r, h, QKN + lane)] = b1; KB[kt_off(r, h, QKN + 16 + lane)] = b2; } }
            { const f32x4 p0 = up4(cur.ah0) * up4(cur.ac0); f32x4 p1 = (f32x4){0.f, 0.f, 0.f, 0.f}, p2 = p1;
              if (t >= 1) p1 = up4(cur.ah1) * up4(cur.ac1); else if (!pr) p1 = *(const f32x4*)(sta + ((size_t)n * 2 + 1) * BRW + c);
              if (t >= 2) p2 = up4(cur.ah2) * up4(cur.ac2); else if (!pr) p2 = *(const f32x4*)(sta + ((size_t)n * 2 + t) * BRW + c);
              const f32x4 cv = w0 * p2 + w1 * p1 + w2 * p0; st4bf(YS + (size_t)r * DM + c, up4(cur.ab) * cv);
              if (pr) { if (t >= SEQ - 2) *(f32x4*)(out + OFF_CAP + (((size_t)L * 2 + (r >> 13)) * 2 + (t - (SEQ - 2))) * BRW + c) = p0; }
              else if (t >= 2) *(f32x4*)(out + OFF_CAS + (((size_t)L * NSEQ_S + n) * 2 + (t - 2)) * BRW + c) = p0; }
            cur = nxt; nxt = nx2;
        }
#undef PREP_ROW
    }
    {
        const float* cfw = I.p(22) + (size_t)L * 31 * BRW; const float* cfb = I.p(23) + L * BRW; const float* lng = I.p(24) + L * BRW; const float* lnb = I.p(25) + L * BRW;
        LAS float* G = (LAS float*)(F.lds + RING_OFF); LAS float* Wl = (LAS float*)(F.lds + RING_OFF + 94 * 256 * 4);
        const int c = 4 * lane; const f32x4 cb4 = *(const f32x4*)(cfb + c), g4 = *(const f32x4*)(lng + c), b4 = *(const f32x4*)(lnb + c);
        for (int u = F.vcu; u < 256; u += F.G) {
            const int b = u >> 7, t0 = (u & 127) * 64; const size_t rb = (size_t)b * SEQ;
            __syncthreads();
            {
                v2u aw[12], gw2[12];
#pragma unroll
                for (int k = 0; k < 12; ++k) { int i = wave + k * NWAVES; i = i < 94 ? i : 93; int tau = t0 - 30 + i; tau = tau < 0 ? 0 : tau; const bf16* Zr = Z + (rb + tau) * INP; aw[k] = *(const v2u*)(Zr + ZC_DV + c); gw2[k] = *(const v2u*)(Zr + ZC_DG + c); }
                f32x4 wv[4];
#pragma unroll
                for (int k = 0; k < 4; ++k) { const int e = F.tid + k * NWAVES * 64; wv[k] = *(const f32x4*)(cfw + 4 * (e < 31 * 64 ? e : 31 * 64 - 1)); }
                asm volatile("" : "+v"(aw[0]), "+v"(aw[1]), "+v"(aw[2]), "+v"(aw[3]), "+v"(aw[4]), "+v"(aw[5]), "+v"(aw[6]), "+v"(aw[7]), "+v"(aw[8]), "+v"(aw[9]), "+v"(aw[10]), "+v"(aw[11]),
                             "+v"(gw2[0]), "+v"(gw2[1]), "+v"(gw2[2]), "+v"(gw2[3]), "+v"(gw2[4]), "+v"(gw2[5]), "+v"(gw2[6]), "+v"(gw2[7]), "+v"(gw2[8]), "+v"(gw2[9]), "+v"(gw2[10]), "+v"(gw2[11]), "+v"(wv[0]), "+v"(wv[1]), "+v"(wv[2]), "+v"(wv[3]));
#pragma unroll
                for (int k = 0; k < 4; ++k) { const int e = F.tid + k * NWAVES * 64; if (e < 31 * 64) *(LAS f32x4*)(Wl + 4 * e) = wv[k]; }
#pragma unroll
                for (int k = 0; k < 12; ++k) { const int i = wave + k * NWAVES; const float keep = (t0 - 30 + i >= 0) ? 1.f : 0.f;
                    const f32x4 a = (f32x4){bflo(aw[k].x), bfhi(aw[k].x), bflo(aw[k].y), bfhi(aw[k].y)}, g = (f32x4){bflo(gw2[k].x), bfhi(gw2[k].x), bflo(gw2[k].y), bfhi(gw2[k].y)};
                    const f32x4 v = (f32x4){a[0] * sigm1(g[0]), a[1] * sigm1(g[1]), a[2] * sigm1(g[2]), a[3] * sigm1(g[3])} * keep;
                    if (i < 94) *(LAS f32x4*)(G + i * 256 + c) = v; } }
            __syncthreads();
            for (int k2 = 0; k2 < 4; ++k2) { const int ir = wave * 8 + 2 * k2; f32x4 a0 = cb4, a1 = cb4;
                f32x4 wprev = (f32x4){0.f, 0.f, 0.f, 0.f};
#pragma unroll 4
                for (int k = 0; k < 32; ++k) { const f32x4 gv = *(LAS f32x4*)(G + (ir + k) * 256 + c); f32x4 wk = wprev; if (k < 31) { wk = *(LAS f32x4*)(Wl + k * 256 + c); a0 += wk * gv; } if (k >= 1) a1 += wprev * gv; wprev = wk; }
#pragma unroll
                for (int h2 = 0; h2 < 2; ++h2) { const f32x4 a = h2 ? a1 : a0; const int irr = ir + h2, t = t0 + irr;
                    const float mean = wave_sum((a[0] + a[1]) + (a[2] + a[3])) * (1.0f / 256.0f); const f32x4 d = a - mean;
                    const float var = wave_sum((d[0] * d[0] + d[1] * d[1]) + (d[2] * d[2] + d[3] * d[3])) * (1.0f / 256.0f); const float rs = __builtin_amdgcn_rsqf(var + LN_EPS);
                    f32x4 y = d * rs * g4 + b4; y = (f32x4){silu1(y[0]), silu1(y[1]), silu1(y[2]), silu1(y[3])};
                    st4bf(YS + (rb + t) * DM + 768 + c, y);
                    if (t >= SEQ - 30) *(f32x4*)(out + OFF_CDP + (((size_t)L * 2 + b) * 30 + (t - (SEQ - 30))) * BRW + c) = *(LAS f32x4*)(G + (irr + 30) * 256 + c); } }
        }
        __syncthreads();
        const float* std_ = I.p(6) + (size_t)L * NSEQ_S * 30 * BRW;
        const bool deal2 = (F.G == 256); const int sd0 = deal2 ? ((F.vcu >= 64 && F.vcu < 128) ? (F.vcu - 64) * NWAVES + wave : NSR) : gw, sdstep = deal2 ? NSR : NGW;
        for (int rs_ = sd0; rs_ < NSR; rs_ += sdstep) { const int n = rs_ >> 2, t = rs_ & 3; const float* st = std_ + (size_t)n * 30 * BRW + c;
            f32x4 gl[4];
#pragma unroll
            for (int j = 0; j < 4; ++j) gl[j] = glu4(Z + (size_t)(NPR + 4 * n + j) * INP, c);
            f32x4 a = cb4;
#pragma unroll 1
            for (int k0 = 0; k0 < 32; k0 += 8) { f32x4 sv[8], wv8[8];
#pragma unroll
                for (int u = 0; u < 8; ++u) { const int k = k0 + u < 31 ? k0 + u : 30, i = t + k; sv[u] = *(const f32x4*)(st + (size_t)(i < 30 ? i : 29) * BRW); wv8[u] = *(const f32x4*)(cfw + k * BRW + c); }
                asm volatile("" : "+v"(sv[0]), "+v"(sv[1]), "+v"(sv[2]), "+v"(sv[3]), "+v"(sv[4]), "+v"(sv[5]), "+v"(sv[6]), "+v"(sv[7]), "+v"(wv8[0]), "+v"(wv8[1]), "+v"(wv8[2]), "+v"(wv8[3]), "+v"(wv8[4]), "+v"(wv8[5]), "+v"(wv8[6]), "+v"(wv8[7]));
#pragma unroll
                for (int u = 0; u < 8; ++u) if (k0 + u < 31) { const int i = t + k0 + u; f32x4 v = sv[u]; if (i >= 30) { const int j = i - 30; v = j == 0 ? gl[0] : j == 1 ? gl[1] : j == 2 ? gl[2] : gl[3]; }
                    a += wv8[u] * v; } }
            const float mean = wave_sum((a[0] + a[1]) + (a[2] + a[3])) * (1.0f / 256.0f); const f32x4 d = a - mean;
            const float var = wave_sum((d[0] * d[0] + d[1] * d[1]) + (d[2] * d[2] + d[3] * d[3])) * (1.0f / 256.0f); const float rs = __builtin_amdgcn_rsqf(var + LN_EPS);
            f32x4 y = d * rs * g4 + b4; y = (f32x4){silu1(y[0]), silu1(y[1]), silu1(y[2]), silu1(y[3])};
            st4bf(YS + (size_t)(NPR + rs_) * DM + 768 + c, y);
            { float* so = out + OFF_CDS + ((size_t)L * NSEQ_S + n) * 30 * BRW + c; f32x4 cp[7];
#pragma unroll
                for (int q = 0; q < 7; ++q) { const int j = t + 4 * q; cp[q] = *(const f32x4*)(st + (size_t)((j < 26 ? j : 25) + 4) * BRW); }
#pragma unroll
                for (int q = 0; q < 7; ++q) { const int j = t + 4 * q; if (j < 26) *(f32x4*)(so + (size_t)j * BRW) = cp[q]; }
                *(f32x4*)(so + (size_t)(26 + t) * BRW) = t == 0 ? gl[0] : t == 1 ? gl[1] : t == 2 ? gl[2] : gl[3]; }
        }
    }
    {
        const float* gmg = I.p(14) + L * BRW; const float* gbs = I.p(16) + L * 4 * 128; const float* gws = I.p(15) + (size_t)L * 4 * 128 * 128;
        const bf16* wsb = (const bf16*)(F.ws + WS_WSB) + (size_t)L * 4 * 128 * 128;
        LAS bf16* vT = (LAS bf16*)(F.lds + RING_OFF);
        const int c = 4 * lane; const f32x4 gg = *(const f32x4*)(gmg + c);
        const int fr = lane & 15, fq = lane >> 4;
        for (int u = F.vcu; u < 128; u += F.G) {
            const size_t r0 = (size_t)u * 128;
            __syncthreads();
            v2u xu[8][2]; float bsa[8]; const int gq = wave >> 1;
#pragma unroll
            for (int it = 0; it < 8; ++it) { const int i = 16 * it + fr; const bf16* Zr = Z + (r0 + i) * INP; bsa[it] = gbs[gq * 128 + i];
#pragma unroll
                for (int ci = 0; ci < 2; ++ci) xu[it][ci] = *(const v2u*)(Zr + ZC_BU + (2 * wave + ci) * 16 + 4 * fq); }
            { v2u xw[16];
#pragma unroll
                for (int k = 0; k < 16; ++k) xw[k] = *(const v2u*)(Z + (r0 + wave * 16 + k) * INP + ZC_BV + c);
                asm volatile("" : "+v"(xw[0]), "+v"(xw[1]), "+v"(xw[2]), "+v"(xw[3]), "+v"(xw[4]), "+v"(xw[5]), "+v"(xw[6]), "+v"(xw[7]), "+v"(xw[8]), "+v"(xw[9]), "+v"(xw[10]), "+v"(xw[11]), "+v"(xw[12]), "+v"(xw[13]), "+v"(xw[14]), "+v"(xw[15]));
#pragma unroll
                for (int k = 0; k < 16; ++k) { const int i = wave * 16 + k; const f32x4 x = (f32x4){bflo(xw[k].x), bfhi(xw[k].x), bflo(xw[k].y), bfhi(xw[k].y)};
                    const f32x4 ge = (f32x4){gelu_tanh(x[0]), gelu_tanh(x[1]), gelu_tanh(x[2]), gelu_tanh(x[3])};
                    const float ss = wave_sum((ge[0] * ge[0] + ge[1] * ge[1]) + (ge[2] * ge[2] + ge[3] * ge[3])); const float rs = __builtin_amdgcn_rsqf(ss * (1.0f / 256.0f) + RMS_EPS);
                    const f32x4 v = ge * rs * gg;
#pragma unroll
                    for (int e = 0; e < 4; ++e) vT[(c + e) * 136 + i] = (bf16)f2bf(v[e]); } }
            __syncthreads();
            const int g = wave >> 1; bf16x8 af[2][4];
#pragma unroll
            for (int ci = 0; ci < 2; ++ci)
#pragma unroll
                for (int ks = 0; ks < 4; ++ks) af[ci][ks] = *(LAS bf16x8*)(vT + ((2 * wave + ci) * 16 + fr) * 136 + 32 * ks + 8 * fq);
            bf16x8 bq[2][4];
#pragma unroll
            for (int ks = 0; ks < 4; ++ks) if (32 * ks <= 15) bq[0][ks] = *(const bf16x8*)(wsb + ((size_t)g * 128 + fr) * 128 + 32 * ks + 8 * fq);
#pragma unroll
            for (int it = 0; it < 8; ++it) { f32x4 acc0 = (f32x4){0.f, 0.f, 0.f, 0.f}, acc1 = acc0;
                if (it + 1 < 8) {
#pragma unroll
                    for (int ks = 0; ks < 4; ++ks) if (32 * ks <= 16 * (it + 1) + 15) bq[(it + 1) & 1][ks] = *(const bf16x8*)(wsb + ((size_t)g * 128 + 16 * (it + 1) + fr) * 128 + 32 * ks + 8 * fq); }
#pragma unroll
                for (int ks = 0; ks < 4; ++ks) if (32 * ks <= 16 * it + 15) { const bf16x8 bfr = bq[it & 1][ks];
                    acc0 = __builtin_amdgcn_mfma_f32_16x16x32_bf16(af[0][ks], bfr, acc0, 0, 0, 0); acc1 = __builtin_amdgcn_mfma_f32_16x16x32_bf16(af[1][ks], bfr, acc1, 0, 0, 0); }
                const int i = 16 * it + fr; const float bsv = bsa[it];
#pragma unroll
                for (int ci = 0; ci < 2; ++ci) { const int c4 = (2 * wave + ci) * 16 + 4 * fq; const v2u xr = xu[it][ci]; const f32x4 x = (f32x4){bflo(xr.x), bfhi(xr.x), bflo(xr.y), bfhi(xr.y)}; const f32x4 a = ci ? acc1 : acc0;
                    const f32x4 y = (f32x4){gelu_tanh(x[0]) * (a[0] + bsv), gelu_tanh(x[1]) * (a[1] + bsv), gelu_tanh(x[2]) * (a[2] + bsv), gelu_tanh(x[3]) * (a[3] + bsv)};
                    st4bf(YS + (r0 + i) * DM + 256 + c4, y); } }
        }
        __syncthreads();
        { const int g = lane >> 4;
          const bool deal2 = (F.G == 256); const int sb0 = deal2 ? ((F.vcu >= 64 && F.vcu < 80) ? (F.vcu - 64) * NWAVES + wave : NSEQ_S) : gw, sbstep = deal2 ? NSEQ_S : NGW;
          for (int n = sb0; n < NSEQ_S; n += sbstep) { f32x4 v[4]; v2u xvr[4], xur[4];
#pragma unroll
            for (int j = 0; j < 4; ++j) { xvr[j] = *(const v2u*)(Z + (size_t)(NPR + 4 * n + j) * INP + ZC_BV + c); xur[j] = *(const v2u*)(Z + (size_t)(NPR + 4 * n + j) * INP + ZC_BU + c); }
            asm volatile("" : "+v"(xvr[0]), "+v"(xvr[1]), "+v"(xvr[2]), "+v"(xvr[3]), "+v"(xur[0]), "+v"(xur[1]), "+v"(xur[2]), "+v"(xur[3]));
#pragma unroll
            for (int j = 0; j < 4; ++j) { const f32x4 x = (f32x4){bflo(xvr[j].x), bfhi(xvr[j].x), bflo(xvr[j].y), bfhi(xvr[j].y)};
                const f32x4 ge = (f32x4){gelu_tanh(x[0]), gelu_tanh(x[1]), gelu_tanh(x[2]), gelu_tanh(x[3])};
                const float ss = wave_sum((ge[0] * ge[0] + ge[1] * ge[1]) + (ge[2] * ge[2] + ge[3] * ge[3])); const float rs = __builtin_amdgcn_rsqf(ss * (1.0f / 256.0f) + RMS_EPS);
                v[j] = ge * rs * gg; *(f32x4*)(out + OFF_VS + (((size_t)L * NSEQ_S + n) * 4 + j) * BRW + c) = v[j]; }
#pragma unroll
            for (int i = 0; i < 4; ++i) { f32x4 o = (f32x4){0.f, 0.f, 0.f, 0.f};
#pragma unroll
                for (int j = 0; j <= i; ++j) o += v[j] * gws[((size_t)g * 128 + i) * 128 + j];
                o += gbs[g * 128 + i]; const f32x4 x = (f32x4){bflo(xur[i].x), bfhi(xur[i].x), bflo(xur[i].y), bfhi(xur[i].y)};
                st4bf(YS + (size_t)(NPR + 4 * n + i) * DM + 256 + c, (f32x4){gelu_tanh(x[0]) * o[0], gelu_tanh(x[1]) * o[1], gelu_tanh(x[2]) * o[2], gelu_tanh(x[3]) * o[3]}); }
          } }
    }
}

__device__ __forceinline__ void p_final(Frame& F, const InPtrs& I) {
    const int gw = F.vcu * NWAVES + F.wave, NGW = F.G * NWAVES, lane = F.lane; const float* ssq = (const float*)(F.ws + WS_SSQ) + 6 * SSQ_STRIDE; const float* fg = I.p(32);
    const bf16* hb = (const bf16*)(F.ws + WS_HB);
    f32x4 g[4];
#pragma unroll
    for (int j = 0; j < 4; ++j) g[j] = *(const f32x4*)(fg + 4 * lane + 256 * j);
    v2u cur[4], nxt[4]; float sc = 0.f, sn = 0.f;
    if (gw < MROWS) { sc = lane < 16 ? ssq[(size_t)gw * 16 + lane] : 0.f;
#pragma unroll
        for (int j = 0; j < 4; ++j) cur[j] = *(const v2u*)(hb + (size_t)gw * DM + 4 * lane + 256 * j); }
    for (int m = gw; m < MROWS; m += NGW) { const int m2 = m + NGW;
        if (m2 < MROWS) { sn = lane < 16 ? ssq[(size_t)m2 * 16 + lane] : 0.f;
#pragma unroll
            for (int j = 0; j < 4; ++j) nxt[j] = *(const v2u*)(hb + (size_t)m2 * DM + 4 * lane + 256 * j); }
        const float rs = __builtin_amdgcn_rsqf(wave_sum(sc) * (1.0f / DM) + RMS_EPS); GAS f32x4* p = (GAS f32x4*)(F.out + (size_t)m * DM) + lane;
#pragma unroll
        for (int j = 0; j < 4; ++j) p[64 * j] = (f32x4){bflo(cur[j].x), bfhi(cur[j].x), bflo(cur[j].y), bfhi(cur[j].y)} * rs * g[j];
        sc = sn;
#pragma unroll
        for (int j = 0; j < 4; ++j) cur[j] = nxt[j]; }
}

template <bool GATED, class Epi>
__device__ __forceinline__ void mini_gemm(LAS unsigned char* lds, const bf16* A, int lda, const bf16* Bt, int ldb, int K, size_t a_sub, size_t b_sub, const bf16* Zg, const Epi& epi, int vcu, int G) {
    int tid_ = threadIdx.x; asm volatile("" : "+v"(tid_));
    const int tid = tid_, lane = tid & 63, fr = lane & 15, fq = lane >> 4; const int wid = __builtin_amdgcn_readfirstlane(tid >> 6);
#define MINI_RED(w) ((LAS float*)(lds + ((w) < 4 ? 32768 + (w) * 8192 : 98304 + ((w) - 4) * 8192)))
    LAS float* red = MINI_RED(wid);
    const int nks = K >> 5;
    for (int item = vcu; item < 256; item += G) {
        const int rb = item >> 4, cb = item & 15;
        pg8::f32x4 acc[2][4];
#pragma unroll
        for (int rt = 0; rt < 2; ++rt)
#pragma unroll
            for (int ct = 0; ct < 4; ++ct) acc[rt][ct] = (pg8::f32x4){0.f, 0.f, 0.f, 0.f};
#pragma unroll 2
        for (int sub = 0; sub < (GATED ? 4 : 1); ++sub) {
            pg8::f32x4 pa[2][4];
#pragma unroll
            for (int rt = 0; rt < 2; ++rt)
#pragma unroll
                for (int ct = 0; ct < 4; ++ct) pa[rt][ct] = GATED ? (pg8::f32x4){0.f, 0.f, 0.f, 0.f} : acc[rt][ct];
            const bf16* Ap = A + (size_t)(rb * 32 + fr) * lda + sub * a_sub + 8 * fq;
            const bf16* Bp = Bt + sub * b_sub + (size_t)(cb * 64 + fr) * ldb + 8 * fq;
            v2u gwv[2][4];
            if (GATED) {
#pragma unroll
                for (int rt = 0; rt < 2; ++rt)
#pragma unroll
                    for (int ct = 0; ct < 4; ++ct) gwv[rt][ct] = *(const v2u*)(Zg + (size_t)(NPR + rb * 32 + 16 * rt + fr) * INP + ZC_GATE + sub * DM + cb * 64 + 16 * ct + 4 * fq); }
            constexpr int NB = GATED ? 1 : 4;
#pragma unroll 1
            for (int ks0 = wid; ks0 < nks; ks0 += NB * NWAVES) {
                bf16x8 a0[NB], a1[NB], b[NB][4];
#pragma unroll
                for (int u = 0; u < NB; ++u) { int ks = ks0 + u * NWAVES; ks = ks < nks ? ks : ks0;
                    a0[u] = *(const bf16x8*)(Ap + 32 * ks); a1[u] = *(const bf16x8*)(Ap + (size_t)16 * lda + 32 * ks);
#pragma unroll
                    for (int ct = 0; ct < 4; ++ct) b[u][ct] = *(const bf16x8*)(Bp + (size_t)16 * ct * ldb + 32 * ks); }
                if constexpr (NB == 1) asm volatile("" : "+v"(a0[0]), "+v"(a1[0]), "+v"(b[0][0]), "+v"(b[0][1]), "+v"(b[0][2]), "+v"(b[0][3]),
                    "+v"(gwv[0][0]), "+v"(gwv[0][1]), "+v"(gwv[0][2]), "+v"(gwv[0][3]), "+v"(gwv[1][0]), "+v"(gwv[1][1]), "+v"(gwv[1][2]), "+v"(gwv[1][3]));
                if constexpr (NB == 4) asm volatile("" : "+v"(a0[0]), "+v"(a0[1]), "+v"(a0[2]), "+v"(a0[3]), "+v"(a1[0]), "+v"(a1[1]), "+v"(a1[2]), "+v"(a1[3]),
                    "+v"(b[0][0]), "+v"(b[0][1]), "+v"(b[0][2]), "+v"(b[0][3]), "+v"(b[1][0]), "+v"(b[1][1]), "+v"(b[1][2]), "+v"(b[1][3]),
                    "+v"(b[2][0]), "+v"(b[2][1]), "+v"(b[2][2]), "+v"(b[2][3]), "+v"(b[3][0]), "+v"(b[3][1]), "+v"(b[3][2]), "+v"(b[3][3]));
#pragma unroll
                for (int u = 0; u < NB; ++u) if (ks0 + u * NWAVES < nks) {
#pragma unroll
                    for (int ct = 0; ct < 4; ++ct) { pa[0][ct] = __builtin_amdgcn_mfma_f32_16x16x32_bf16(b[u][ct], a0[u], pa[0][ct], 0, 0, 0); pa[1][ct] = __builtin_amdgcn_mfma_f32_16x16x32_bf16(b[u][ct], a1[u], pa[1][ct], 0, 0, 0); } }
            }
            if (GATED) {
#pragma unroll
                for (int rt = 0; rt < 2; ++rt)
#pragma unroll
                    for (int ct = 0; ct < 4; ++ct) { const v2u gw = gwv[rt][ct];
                        acc[rt][ct] += pa[rt][ct] * (pg8::f32x4){bflo(gw.x), bfhi(gw.x), bflo(gw.y), bfhi(gw.y)}; }
            } else {
#pragma unroll
                for (int rt = 0; rt < 2; ++rt)
#pragma unroll
                    for (int ct = 0; ct < 4; ++ct) acc[rt][ct] = pa[rt][ct];
            }
        }
#pragma unroll
        for (int rt = 0; rt < 2; ++rt)
#pragma unroll
            for (int ct = 0; ct < 4; ++ct) *(LAS pg8::f32x4*)(red + ((16 * rt + fr) * 64 + 16 * ct + 4 * fq)) = acc[rt][ct];
        __syncthreads();
        { const int r = tid >> 4, c4 = (tid & 15) * 4; pg8::f32x4 v = *(LAS pg8::f32x4*)(MINI_RED(0) + (r * 64 + c4));
#pragma unroll
          for (int w = 1; w < NWAVES; ++w) v += *(LAS pg8::f32x4*)(MINI_RED(w) + (r * 64 + c4));
          epi(NPR + rb * 32 + r, cb * 64 + c4, v, lane); }
        __syncthreads();
    }
#undef MINI_RED
}
struct MiniRes { bf16* hb; float* ssq_out; float scale;
    __device__ __forceinline__ void operator()(int row, int col, pg8::f32x4 v, int lane) const {
        bf16* hp = hb + (size_t)row * DM + col; const pg8::f32x4 o = ld4bf(hp) + v * scale; st4bf(hp, o);
        float sq = (o[0] * o[0] + o[1] * o[1]) + (o[2] * o[2] + o[3] * o[3]);
        sq = xadd8(xadd4(xadd2(xadd1(sq))));
        if ((lane & 15) == 0) ssq_out[(size_t)row * 16 + (col >> 6)] = sq; } };
struct MiniBranch { bf16* mg;
    __device__ __forceinline__ void operator()(int row, int col, pg8::f32x4 v, int) const { st4bf(mg + (size_t)row * DM + col, v); } };
struct MiniMla { bf16* Qb; bf16* Kb; bf16* Vb; const float* rope;
    __device__ __forceinline__ void operator()(int row, int col, pg8::f32x4 v, int lane) const {
        pg8::f32x4 pv; pv[0] = __shfl_xor(v[0], 4); pv[1] = __shfl_xor(v[1], 4); pv[2] = __shfl_xor(v[2], 4); pv[3] = __shfl_xor(v[3], 4);
        if (col < 384) { const int g32 = col >> 5;
            if (g32 % 3 == 2) { const int pos = SEQ + (row & 3); const int i0 = col & 15; const bool second = (col & 16) != 0;
                const pg8::f32x4 cs = *(const pg8::f32x4*)(rope + (size_t)pos * 32 + i0), sn = *(const pg8::f32x4*)(rope + (size_t)pos * 32 + 16 + i0);
                v = second ? (v * cs + pv * sn) : (v * cs - pv * sn); }
            st4bf(Qb + (size_t)row * 384 + col, v * ATT_C2); }
    } };

namespace att {
using f32x16 = __attribute__((ext_vector_type(16))) float;
using s16x4 = __attribute__((ext_vector_type(4))) short;
typedef short v4i16_t __attribute__((ext_vector_type(4)));
typedef LAS const char* lds_cptr;
constexpr int KT_BYTES = 12288, VT_BYTES = 8192, SLOT = 2 * KT_BYTES + 2 * VT_BYTES  , NSLOT = 3, LDS_WSF = NSLOT * SLOT  , LDS_END = LDS_WSF + 8 * 256;
static_assert(LDS_END <= RING_BYTES, "attention LDS");
__device__ __forceinline__ int crow(int r, int hi) { return (r & 3) + 8 * (r >> 2) + 4 * hi; }
__device__ __forceinline__ void glds16(const void* gsrc, unsigned lds_dst) { unsigned keep;
    asm volatile("s_mov_b32 %0, m0\n\ts_mov_b32 m0, %2\n\ts_nop 0\n\tglobal_load_lds_dwordx4 %1, off\n\ts_mov_b32 m0, %0" : "=&s"(keep) : "v"(gsrc), "s"(lds_dst) : "memory"); }
__device__ __forceinline__ void glds16s(const void* sbase, unsigned voff, unsigned lds_dst) { unsigned keep;
    asm volatile("s_mov_b32 %0, m0\n\ts_mov_b32 m0, %3\n\ts_nop 0\n\tglobal_load_lds_dwordx4 %1, %2\n\ts_mov_b32 m0, %0" : "=&s"(keep) : "v"(voff), "s"(sbase), "s"(lds_dst) : "memory"); }
typedef float f32x2_t __attribute__((ext_vector_type(2))); typedef __bf16 bf16x2_t __attribute__((ext_vector_type(2)));
__device__ __forceinline__ unsigned cvtpk(float lo, float hi) { f32x2_t v = {lo, hi}; bf16x2_t b = __builtin_convertvector(v, bf16x2_t); return __builtin_bit_cast(unsigned, b); }
#define ATT_WAIT_BAR(N) asm volatile("s_waitcnt vmcnt(" #N ") lgkmcnt(0)\n\ts_barrier" ::: "memory")
__device__ __forceinline__ s16x4 vtr(lds_cptr p) { return __builtin_bit_cast(s16x4, __builtin_amdgcn_ds_read_tr16_b64_v4i16((LAS v4i16_t*)p)); }

constexpr float FL_THR = 8.0f;
template <bool MASK, bool SPEC>
__device__ __forceinline__ void flash_softmax_half(const int hsel, f32x16 p, f32x16 (&o)[2], float& m, float& l, v4u (&pw)[4], int kbase, int qrel, int r32, int hi) {
    if (MASK) { asm volatile("" : "+v"(qrel));
#pragma unroll
        for (int r = 0; r < 16; ++r) { const int kv = kbase + 32 * hsel + crow(r, hi); if (kv > qrel) p[r] = -INFINITY; } }
    float rm = __builtin_fmaxf(p[0], p[1]);
#pragma unroll
    for (int r = 2; r < 16; ++r) rm = __builtin_fmaxf(rm, p[r]);
    rm = xmax32(rm);
    float sacc = 0.f; f32x2 sacc2 = (f32x2){0.f, 0.f};
    if (SPEC) {
#pragma unroll
        for (int r = 0; r < 16; r += 2) { f32x2 x = (f32x2){p[r], p[r + 1]} - (f32x2){m, m}; x = (f32x2){__builtin_amdgcn_exp2f(x[0]), __builtin_amdgcn_exp2f(x[1])}; p[r] = x[0]; p[r + 1] = x[1]; sacc2 += x; }
        pw[2 * hsel] = (v4u){cvtpk(p[0], p[1]), cvtpk(p[2], p[3]), cvtpk(p[4], p[5]), cvtpk(p[6], p[7])};
        pw[2 * hsel + 1] = (v4u){cvtpk(p[8], p[9]), cvtpk(p[10], p[11]), cvtpk(p[12], p[13]), cvtpk(p[14], p[15])}; }
    if (__any(rm > m + FL_THR)) {
        const float mnew = __builtin_fmaxf(m, rm); const float f = __builtin_amdgcn_exp2f(m - mnew); l *= f; m = mnew;
#pragma unroll
        for (int r = 0; r < 16; ++r) { const int src = (r & 3) + 8 * (r >> 2);
            const float fa = __builtin_bit_cast(float, __builtin_amdgcn_readlane(__builtin_bit_cast(int, f), src)), fb = __builtin_bit_cast(float, __builtin_amdgcn_readlane(__builtin_bit_cast(int, f), src + 4));
            const float fr_ = hi ? fb : fa; o[0][r] *= fr_; o[1][r] *= fr_; }
#pragma unroll
        for (int k = 0; k < 4; ++k) if (k < 2 * hsel + (SPEC ? 2 : 0)) {
#pragma unroll
            for (int e = 0; e < 4; ++e) { const unsigned w = pw[k][e]; pw[k][e] = cvtpk(bflo(w) * f, bfhi(w) * f); } }
        if (SPEC) sacc2 = sacc2 * f; }
    if (!SPEC) {
#pragma unroll
        for (int r = 0; r < 16; r += 2) { f32x2 x = (f32x2){p[r], p[r + 1]} - (f32x2){m, m}; x = (f32x2){__builtin_amdgcn_exp2f(x[0]), __builtin_amdgcn_exp2f(x[1])}; p[r] = x[0]; p[r + 1] = x[1]; sacc2 += x; }
        pw[2 * hsel] = (v4u){cvtpk(p[0], p[1]), cvtpk(p[2], p[3]), cvtpk(p[4], p[5]), cvtpk(p[6], p[7])};
        pw[2 * hsel + 1] = (v4u){cvtpk(p[8], p[9]), cvtpk(p[10], p[11]), cvtpk(p[12], p[13]), cvtpk(p[14], p[15])}; }
    l += sacc + (sacc2[0] + sacc2[1]);
}
template <bool PV, bool QK, bool MASK, bool SPEC>
__device__ __forceinline__ void flash_step(f32x16 (&o)[2], float& m, float& l, v4u (&pw)[4], lds_cptr Kt, lds_cptr Vt, lds_cptr Qt0, int kbase, int wq, int lane) {
    asm volatile("" : "+v"(lane));
    const int r32 = lane & 31, hi = lane >> 5, qrel = wq * 32 + r32; const lds_cptr Qt = Qt0 + (wq * 32 + r32) * QT_STRIDE + hi * 16;
    bf16x8 qr[6];
    if (QK) {
#pragma unroll
        for (int d0 = 0; d0 < 6; ++d0) qr[d0] = *(LAS const bf16x8*)(Qt + d0 * 32); }
    lds_cptr kb = Kt + hi * 1024 + r32 * 16;
    lds_cptr vp = Vt + ((r32 >> 4) & 1) * 32 + (r32 & 3) * 8 + (4 * hi + ((r32 & 15) >> 2)) * 64;
    f32x16 pc0 = f32x16{}, pc1 = f32x16{};
    { bf16x8 kfa[6];
      if (QK) {
#pragma unroll
        for (int d0 = 0; d0 < 6; ++d0) kfa[d0] = *(LAS const bf16x8*)(kb + d0 * 2048); }
      __builtin_amdgcn_sched_barrier(0x0407);
      if (QK) {
#pragma unroll
        for (int d0 = 0; d0 < 6; ++d0) pc0 = __builtin_amdgcn_mfma_f32_32x32x16_bf16(kfa[d0], qr[d0], pc0, 0, 0, 0); } }
    { s16x4 vlo[4], vhi[4];
      if (PV) {
#pragma unroll
        for (int ks = 0; ks < 2; ++ks)
#pragma unroll
            for (int d0 = 0; d0 < 2; ++d0) { vlo[ks * 2 + d0] = vtr(vp + d0 * 4096 + ks * 1024); vhi[ks * 2 + d0] = vtr(vp + d0 * 4096 + ks * 1024 + 512); } }
      __builtin_amdgcn_sched_barrier(0x0407);
      if (PV) {
#pragma unroll
        for (int ks = 0; ks < 2; ++ks)
#pragma unroll
            for (int d0 = 0; d0 < 2; ++d0) { const int i = ks * 2 + d0;
                const bf16x8 vf = (bf16x8){vlo[i][0], vlo[i][1], vlo[i][2], vlo[i][3], vhi[i][0], vhi[i][1], vhi[i][2], vhi[i][3]};
                o[d0] = __builtin_amdgcn_mfma_f32_32x32x16_bf16(__builtin_bit_cast(bf16x8, pw[ks]), vf, o[d0], 0, 0, 0); } } }
    { bf16x8 kfb[6];
      if (QK) {
#pragma unroll
        for (int d0 = 0; d0 < 6; ++d0) kfb[d0] = *(LAS const bf16x8*)(kb + d0 * 2048 + 512); }
      __builtin_amdgcn_sched_barrier(0x0407);
      if (QK) {
#pragma unroll
        for (int d0 = 0; d0 < 6; ++d0) pc1 = __builtin_amdgcn_mfma_f32_32x32x16_bf16(kfb[d0], qr[d0], pc1, 0, 0, 0); } }
    { s16x4 vlo[4], vhi[4];
      if (PV) {
#pragma unroll
        for (int ks = 0; ks < 2; ++ks)
#pragma unroll
            for (int d0 = 0; d0 < 2; ++d0) { vlo[ks * 2 + d0] = vtr(vp + d0 * 4096 + (2 + ks) * 1024); vhi[ks * 2 + d0] = vtr(vp + d0 * 4096 + (2 + ks) * 1024 + 512); } }
      __builtin_amdgcn_sched_barrier(0x0407);
      if (PV) {
#pragma unroll
        for (int ks = 0; ks < 2; ++ks)
#pragma unroll
            for (int d0 = 0; d0 < 2; ++d0) { const int i = ks * 2 + d0;
                const bf16x8 vf = (bf16x8){vlo[i][0], vlo[i][1], vlo[i][2], vlo[i][3], vhi[i][0], vhi[i][1], vhi[i][2], vhi[i][3]};
                o[d0] = __builtin_amdgcn_mfma_f32_32x32x16_bf16(__builtin_bit_cast(bf16x8, pw[2 + ks]), vf, o[d0], 0, 0, 0); } }
      __builtin_amdgcn_sched_barrier(0x0407); }
    if (QK) { flash_softmax_half<MASK, SPEC>(0, pc0, o, m, l, pw, kbase, qrel, r32, hi);
              flash_softmax_half<MASK, false>(1, pc1, o, m, l, pw, kbase, qrel, r32, hi); }
}

__device__ __forceinline__ void flash_unit(int b, int h, int qb, const bf16* Qb, const bf16* Kb, const bf16* Vb, bf16* YS, LAS unsigned char* lds) {
    int tid_ = threadIdx.x; asm volatile("" : "+v"(tid_));
    const int tid = tid_, lane = tid & 63, r32 = lane & 31, hi = lane >> 5; const int wid = __builtin_amdgcn_readfirstlane(tid >> 6);
    const int g = wid >> 2, wq = wid & 3;
    const size_t rowbase = (size_t)b * SEQ; const int q0 = qb * 128; const int n = qb + 1;
    const unsigned lds0 = (unsigned)(uintptr_t)lds;
    LAS float* wsf = (LAS float*)(lds + LDS_WSF) + wid * 64;
    { const bf16* Qg = Qb + (rowbase + q0) * 384 + h * QKD;
#pragma unroll
      for (int i = 0; i < 3; ++i) { const int ch = tid + 512 * i, row = ch / 12, c = ch - row * 12;
          const v4u v = *(const v4u*)(Qg + (size_t)row * 384 + c * 8); *(LAS v4u*)(lds + QTILE_OFF + row * QT_STRIDE + c * 16) = v; } }
    const lds_cptr Qt0 = (lds_cptr)lds + QTILE_OFF;
    constexpr int KSL = 2 * KT_BYTES, VSL = 2 * VT_BYTES, KRING = 3 * KSL;
    const bf16* Kl = Kb + (size_t)(b * 4 + h) * SEQ * 96; const bf16* Vl = Vb + (size_t)(b * 4 + h) * SEQ * 64; const unsigned lo16 = (unsigned)lane * 16u;
    const int c1 = wid < 4 ? 8 + wid : wid - 4; const int t1 = wid < 4 ? 0 : 1;
    const int ko0 = wid * 512, ko1 = t1 * 6144 + c1 * 512, ko2 = 6144 + (wid + 4) * 512, vo0 = wid * 512, vo1 = 4096 + wid * 512;
    const unsigned kd0 = lds0 + wid * 1024, kd1 = lds0 + t1 * KT_BYTES + c1 * 1024, kd2 = lds0 + KT_BYTES + (wid + 4) * 1024;
    const unsigned vd0 = lds0 + KRING + wid * 1024, vd1 = vd0 + VT_BYTES;
#if defined(FPROBE) && (FPROBE & 8)
#define GLDS2(a, b) do { glds16s(a, lo16, b); glds16s(a, lo16, b); } while (0)
#define WB5() ATT_WAIT_BAR(10)
#define WB2() ATT_WAIT_BAR(4)
#else
#define GLDS2(a, b) glds16s(a, lo16, b)
#define WB5() ATT_WAIT_BAR(5)
#define WB2() ATT_WAIT_BAR(2)
#endif
#define ATT_KDMA(t, slot) do { const int ko_ = (t) * 2 * 6144; const unsigned so_ = (unsigned)(slot) * KSL; \
        GLDS2(Kl + (ko_ + ko0), (unsigned)__builtin_amdgcn_readfirstlane(kd0 + so_)); GLDS2(Kl + (ko_ + ko1), (unsigned)__builtin_amdgcn_readfirstlane(kd1 + so_)); \
        GLDS2(Kl + (ko_ + ko2), (unsigned)__builtin_amdgcn_readfirstlane(kd2 + so_)); } while (0)
#define ATT_VDMA(t, slot) do { const int vo_ = (t) * 2 * 4096; const unsigned so_ = (unsigned)(slot) * VSL; \
        GLDS2(Vl + (vo_ + vo0), (unsigned)__builtin_amdgcn_readfirstlane(vd0 + so_)); GLDS2(Vl + (vo_ + vo1), (unsigned)__builtin_amdgcn_readfirstlane(vd1 + so_)); } while (0)
#define ATT_KP(slot) ((lds_cptr)lds + (slot) * KSL + g * KT_BYTES)
#define ATT_VP(slot) ((lds_cptr)lds + KRING + (slot) * VSL + g * VT_BYTES)
    ATT_KDMA(0, 0); if (n > 1) ATT_KDMA(1, 1); ATT_VDMA(0, 0);
    float m = -1e30f, l = 0.f; f32x16 o[2]; o[0] = f32x16{}; o[1] = f32x16{}; v4u pw[4];
#pragma unroll
    for (int k = 0; k < 4; ++k) pw[k] = (v4u){0u, 0u, 0u, 0u};
    if (n > 1) WB5(); else WB2();
    if (n > 2) ATT_KDMA(2, 2); if (n > 1) ATT_VDMA(1, 1);
    if (n == 1) flash_step<false, true, true, false>(o, m, l, pw, ATT_KP(0), ATT_VP(0), Qt0, 64 * g, wq, lane);
    else flash_step<false, true, false, false>(o, m, l, pw, ATT_KP(0), ATT_VP(0), Qt0, 64 * g, wq, lane);
    { int ks = 1, vs = 0, ks2 = 0, vs1 = 2;
      for (int i = 1; i < n; ++i) {
        if (i + 1 < n) WB5(); else WB2();
        if (i + 2 < n) ATT_KDMA(i + 2, ks2); if (i + 1 < n) ATT_VDMA(i + 1, vs1);
        if (i == n - 1) flash_step<true, true, true, false>(o, m, l, pw, ATT_KP(ks), ATT_VP(vs), Qt0, 64 * g, wq, lane);
        else flash_step<true, true, false, true>(o, m, l, pw, ATT_KP(ks), ATT_VP(vs), Qt0, 64 * g, wq, lane);
        ks = ks == 2 ? 0 : ks + 1; vs = vs == 2 ? 0 : vs + 1; ks2 = ks2 == 2 ? 0 : ks2 + 1; vs1 = vs1 == 2 ? 0 : vs1 + 1;
      } }
    ATT_WAIT_BAR(0);
    flash_step<true, false, false, false>(o, m, l, pw, ATT_KP(0), ATT_VP((n - 1) % 3), Qt0, 64 * g, wq, lane);
#undef ATT_KDMA
#undef GLDS2
#undef WB5
#undef WB2
#undef ATT_VDMA
#undef ATT_KP
#undef ATT_VP
    ATT_WAIT_BAR(0);
    int lane2 = lane; asm volatile("" : "+v"(lane2));
    LAS float* mb = (LAS float*)(lds + KSL) + (wq * 64 + lane2) * 34;
    if (g == 1) {
#pragma unroll
        for (int r = 0; r < 16; ++r) { mb[r] = o[0][r]; mb[16 + r] = o[1][r]; }
        mb[32] = m; mb[33] = l; }
    ATT_WAIT_BAR(0);
    if (g == 0) {
        const float m1 = mb[32], l1 = mb[33]; const float mm = __builtin_fmaxf(m, m1); const float f0 = __builtin_amdgcn_exp2f(m - mm), f1 = __builtin_amdgcn_exp2f(m1 - mm);
        float lt = xadd32(l * f0 + l1 * f1); const float inv = 1.0f / lt;
        if (hi == 0) { wsf[r32] = f0 * inv; wsf[32 + r32] = f1 * inv; }
        asm volatile("s_waitcnt lgkmcnt(0)" ::: "memory");
        LAS bf16* stg = (LAS bf16*)(lds) + wq * 2048;
#pragma unroll
        for (int r = 0; r < 16; ++r) { const int orow = crow(r, hi); const float a0 = wsf[orow], a1 = wsf[32 + orow];
            stg[orow * 64 + r32] = (bf16)f2bf(o[0][r] * a0 + mb[r] * a1); stg[orow * 64 + 32 + r32] = (bf16)f2bf(o[1][r] * a0 + mb[16 + r] * a1); }
        asm volatile("s_waitcnt lgkmcnt(0)" ::: "memory");
        bf16* Ow = YS + (rowbase + q0 + wq * 32) * DM + 512 + h * VHD;
#pragma unroll
        for (int i = 0; i < 4; ++i) { const int row = i * 8 + (lane2 >> 3), ch = lane2 & 7; const v4u v = *(LAS const v4u*)(stg + row * 64 + ch * 8); *(v4u*)(Ow + (size_t)row * DM + ch * 8) = v; }
    }
    ATT_WAIT_BAR(0);
}

constexpr int DK_STRIDE = 336  , DK_TILE = 32 * DK_STRIDE  , DEC_QS = 8 * DK_TILE  , DEC_QS_STRIDE = 336, DEC_ML = DEC_QS + 16 * DEC_QS_STRIDE  ,
              DEC_OL = DEC_ML + 2 * 8 * 16 * 4  , DEC_END = DEC_OL + 16 * 128 * 4;
static_assert(DEC_END <= RING_BYTES && 8 * 128 * 16 * 4 <= DEC_QS, "decode LDS");
__device__ __forceinline__ void decode_seq(int n, int L, const InPtrs& I, const bf16* Qb, const float* outp, bf16* YS, LAS unsigned char* lds) {
    int tid_ = threadIdx.x; asm volatile("" : "+v"(tid_));
    const int tid = tid_, lane = tid & 63, fr = lane & 15, fq = lane >> 4; const int wid = __builtin_amdgcn_readfirstlane(tid >> 6);
    const float* wuk = I.p(20) + (size_t)L * KVR * 256; const float* wuv = I.p(21) + (size_t)L * KVR * 256;
    const float* clat = I.p(2) + (size_t)L * NPOOL * PAGE * KVR; const float* ckr = I.p(3) + (size_t)L * NPOOL * PAGE * QKR; const int* ptab = (const int*)I.p(4) + n * NPAGES;
    const float* nlat = outp + OFF_LATS + ((size_t)L * NSR + 4 * n) * KVR; const float* nkr = outp + OFF_KRS + ((size_t)L * NSR + 4 * n) * QKR;
    LAS unsigned char* Qs = lds + DEC_QS;
    f32x4 xl[16], xk[4];
#if defined(DEC_PLAIN)
#define DEC_LD(p) (*(p))
#else
#define DEC_LD(p) __builtin_nontemporal_load(p)
#endif
    int pid_cur = ptab[wid], pid_nxt = ptab[wid + NWAVES];
#define DEC_LOAD(jt) do { const int pid_ = pid_cur; const int k0_ = ((jt) & 3) * 32; \
        const float* lp_ = clat + (size_t)pid_ * PAGE * KVR + (size_t)(k0_ + (lane >> 5)) * KVR + (lane & 31) * 4; const float* kp_ = ckr + (size_t)pid_ * PAGE * QKR + (size_t)(k0_ + (lane >> 3)) * QKR + (lane & 7) * 4; \
        _Pragma("unroll") for (int i = 0; i < 16; ++i) xl[i] = DEC_LD((const f32x4*)(lp_ + (size_t)(2 * i) * KVR)); \
        _Pragma("unroll") for (int i = 0; i < 4; ++i) xk[i] = DEC_LD((const f32x4*)(kp_ + (size_t)(8 * i) * QKR)); } while (0)
    DEC_LOAD(0);
    __syncthreads();
    { const int j = tid >> 5, t = j >> 2, h = j & 3, cg = (tid & 31) * 4; const bf16* q = Qb + (size_t)(NPR + 4 * n + t) * 384 + h * QKD;
      float a[4] = {0.f, 0.f, 0.f, 0.f};
#pragma unroll 1
      for (int d = 0; d < QKN; d += 16) { f32x4 wv[16]; f32x4 qv[4];
#pragma unroll
          for (int i = 0; i < 4; ++i) { qv[i] = ld4bf(q + d + 4 * i);
#pragma unroll
              for (int e = 0; e < 4; ++e) wv[4 * i + e] = *(const f32x4*)(wuk + (size_t)(cg + e) * 256 + h * QKN + d + 4 * i); }
          asm volatile("" : "+v"(wv[0]), "+v"(wv[1]), "+v"(wv[2]), "+v"(wv[3]), "+v"(wv[4]), "+v"(wv[5]), "+v"(wv[6]), "+v"(wv[7]), "+v"(wv[8]), "+v"(wv[9]), "+v"(wv[10]), "+v"(wv[11]), "+v"(wv[12]), "+v"(wv[13]), "+v"(wv[14]), "+v"(wv[15]));
#pragma unroll
          for (int i = 0; i < 4; ++i)
#pragma unroll
              for (int e = 0; e < 4; ++e) { const f32x4 w = wv[4 * i + e]; a[e] += (qv[i][0] * w[0] + qv[i][1] * w[1]) + (qv[i][2] * w[2] + qv[i][3] * w[3]); } }
      v2u pk; pk.x = pk2(a[0], a[1]); pk.y = pk2(a[2], a[3]); *(LAS v2u*)(Qs + j * DEC_QS_STRIDE + cg * 2) = pk;
      if ((tid & 31) < 8) *(LAS v2u*)(Qs + j * DEC_QS_STRIDE + 256 + (tid & 31) * 8) = *(const v2u*)(q + QKN + (tid & 31) * 4); }
    __syncthreads();
    bf16x8 qf[5];
#pragma unroll
    for (int ks = 0; ks < 5; ++ks) qf[ks] = *(LAS const bf16x8*)(Qs + fr * DEC_QS_STRIDE + (32 * ks + 8 * fq) * 2);
    LAS unsigned char* Kt = lds + wid * DK_TILE;
    float m = -1e30f, l = 0.f; f32x4 o[8];
#pragma unroll
    for (int ct = 0; ct < 8; ++ct) o[ct] = (f32x4){0.f, 0.f, 0.f, 0.f};
#pragma unroll 1
    for (int jt = 0; jt < 32; ++jt) { {
#pragma unroll
            for (int i = 0; i < 16; ++i) { v2u w; w.x = cvtpk(xl[i][0], xl[i][1]); w.y = cvtpk(xl[i][2], xl[i][3]); *(LAS v2u*)(Kt + (2 * i + (lane >> 5)) * DK_STRIDE + (lane & 31) * 8) = w; }
#pragma unroll
            for (int i = 0; i < 4; ++i) { v2u w; w.x = cvtpk(xk[i][0], xk[i][1]); w.y = cvtpk(xk[i][2], xk[i][3]); *(LAS v2u*)(Kt + (8 * i + (lane >> 3)) * DK_STRIDE + 256 + (lane & 7) * 8) = w; }
            if (jt + 1 < 32) { if (((jt + 1) & 3) == 0) { pid_cur = pid_nxt; if (jt + 5 < 32) pid_nxt = ptab[wid + NWAVES * ((jt + 5) >> 2)]; } DEC_LOAD(jt + 1); }
            asm volatile("s_waitcnt lgkmcnt(0)" ::: "memory");
            f32x4 s0 = (f32x4){0.f, 0.f, 0.f, 0.f}, s1 = s0;
#pragma unroll
            for (int ks = 0; ks < 5; ++ks) { const bf16x8 a0 = *(LAS const bf16x8*)(Kt + fr * DK_STRIDE + (32 * ks + 8 * fq) * 2), a1 = *(LAS const bf16x8*)(Kt + (16 + fr) * DK_STRIDE + (32 * ks + 8 * fq) * 2);
                s0 = __builtin_amdgcn_mfma_f32_16x16x32_bf16(a0, qf[ks], s0, 0, 0, 0); s1 = __builtin_amdgcn_mfma_f32_16x16x32_bf16(a1, qf[ks], s1, 0, 0, 0); }
            float rm = __builtin_fmaxf(__builtin_fmaxf(__builtin_fmaxf(s0[0], s0[1]), __builtin_fmaxf(s0[2], s0[3])), __builtin_fmaxf(__builtin_fmaxf(s1[0], s1[1]), __builtin_fmaxf(s1[2], s1[3])));
            rm = xmax32(xmax16(rm));
            const float mnew = __builtin_fmaxf(m, rm); const float f = __builtin_amdgcn_exp2f(m - mnew); m = mnew;
#pragma unroll
            for (int e = 0; e < 4; ++e) { s0[e] = __builtin_amdgcn_exp2f(s0[e] - m); s1[e] = __builtin_amdgcn_exp2f(s1[e] - m); }
            l = l * f + ((s0[0] + s0[1]) + (s0[2] + s0[3])) + ((s1[0] + s1[1]) + (s1[2] + s1[3]));
            const v4u pw = (v4u){cvtpk(s0[0], s0[1]), cvtpk(s0[2], s0[3]), cvtpk(s1[0], s1[1]), cvtpk(s1[2], s1[3])}; const bf16x8 pb = __builtin_bit_cast(bf16x8, pw);
            lds_cptr vp = (lds_cptr)Kt + (4 * fq + (fr >> 2)) * DK_STRIDE + (fr & 3) * 8;
#pragma unroll
            for (int ct = 0; ct < 8; ++ct) { const s16x4 lo = vtr(vp + ct * 32), hh = vtr(vp + 16 * DK_STRIDE + ct * 32);
                const bf16x8 vf = (bf16x8){lo[0], lo[1], lo[2], lo[3], hh[0], hh[1], hh[2], hh[3]};
                o[ct] = o[ct] * f; o[ct] = __builtin_amdgcn_mfma_f32_16x16x32_bf16(vf, pb, o[ct], 0, 0, 0); }
            asm volatile("s_waitcnt lgkmcnt(0)" ::: "memory");
        } }
#undef DEC_LOAD
    l = xadd32(xadd16(l));
    __syncthreads();
    LAS float* OM = (LAS float*)lds;
    LAS float* Mw = (LAS float*)(lds + DEC_ML); LAS float* Lw = Mw + 8 * 16;
#pragma unroll
    for (int ct = 0; ct < 8; ++ct)
#pragma unroll
        for (int e = 0; e < 4; ++e) OM[(wid * 128 + 16 * ct + 4 * fq + e) * 16 + fr] = o[ct][e];
    if (fq == 0) { Mw[wid * 16 + fr] = m; Lw[wid * 16 + fr] = l; }
    __syncthreads();
    LAS float* OL = (LAS float*)(lds + DEC_OL);
    { const int q = tid & 15, t = q >> 2, cg = (tid >> 4) * 4;
      float sn[4]; float mm = -1e30f;
#pragma unroll
      for (int w = 0; w < 8; ++w) mm = __builtin_fmaxf(mm, Mw[w * 16 + q]);
      sn[0] = 0.f; sn[1] = 0.f; sn[2] = 0.f; sn[3] = 0.f;
#define DEC_SCORE(SRC, LD, QOFF, N) _Pragma("unroll 1") for (int d = 0; d < (N); d += 16) { f32x4 kv[16]; \
          _Pragma("unroll") for (int s = 0; s < 4; ++s) _Pragma("unroll") for (int j = 0; j < 4; ++j) kv[s * 4 + j] = *(const f32x4*)((SRC) + s * (LD) + d + 4 * j); \
          asm volatile("" : "+v"(kv[0]), "+v"(kv[1]), "+v"(kv[2]), "+v"(kv[3]), "+v"(kv[4]), "+v"(kv[5]), "+v"(kv[6]), "+v"(kv[7]), "+v"(kv[8]), "+v"(kv[9]), "+v"(kv[10]), "+v"(kv[11]), "+v"(kv[12]), "+v"(kv[13]), "+v"(kv[14]), "+v"(kv[15])); \
          _Pragma("unroll") for (int j = 0; j < 4; ++j) { const v2u qw = *(LAS const v2u*)(Qs + q * DEC_QS_STRIDE + (QOFF) + (d + 4 * j) * 2); const float x0 = bflo(qw.x), x1 = bfhi(qw.x), x2 = bflo(qw.y), x3 = bfhi(qw.y); \
              _Pragma("unroll") for (int s = 0; s < 4; ++s) { const f32x4 k4 = kv[s * 4 + j]; sn[s] += x0 * k4[0] + x1 * k4[1]; sn[s] += x2 * k4[2] + x3 * k4[3]; } } }
      DEC_SCORE(nlat, KVR, 0, KVR)
      DEC_SCORE(nkr, QKR, 256, QKR)
#undef DEC_SCORE
#pragma unroll
      for (int s = 0; s < 4; ++s) { if (s > t) sn[s] = -INFINITY; mm = __builtin_fmaxf(mm, sn[s]); }
      float ls = 0.f; float acc[4] = {0.f, 0.f, 0.f, 0.f};
#pragma unroll
      for (int w = 0; w < 8; ++w) { const float fw = __builtin_amdgcn_exp2f(Mw[w * 16 + q] - mm); ls += Lw[w * 16 + q] * fw;
#pragma unroll
          for (int e = 0; e < 4; ++e) acc[e] += OM[(w * 128 + cg + e) * 16 + q] * fw; }
      f32x4 nl4[4];
#pragma unroll
      for (int s = 0; s < 4; ++s) nl4[s] = *(const f32x4*)(nlat + s * KVR + cg);
      asm volatile("" : "+v"(nl4[0]), "+v"(nl4[1]), "+v"(nl4[2]), "+v"(nl4[3]));
#pragma unroll
      for (int s = 0; s < 4; ++s) { const float ps = __builtin_amdgcn_exp2f(sn[s] - mm); ls += ps;
#pragma unroll
          for (int e = 0; e < 4; ++e) acc[e] += ps * nl4[s][e]; }
      const float inv = 1.0f / ls;
#pragma unroll
      for (int e = 0; e < 4; ++e) OL[q * 128 + cg + e] = acc[e] * inv; }
    __syncthreads();
    { const int q = tid >> 5, t = q >> 2, h = q & 3, d = (tid & 31) * 2; float a0 = 0.f, a1 = 0.f;
#pragma unroll 1
      for (int c0 = 0; c0 < KVR; c0 += 16) { f32x2 wv[16];
#pragma unroll
          for (int k = 0; k < 16; ++k) wv[k] = *(const f32x2*)(wuv + (size_t)(c0 + k) * 256 + h * VHD + d);
          asm volatile("" : "+v"(wv[0]), "+v"(wv[1]), "+v"(wv[2]), "+v"(wv[3]), "+v"(wv[4]), "+v"(wv[5]), "+v"(wv[6]), "+v"(wv[7]), "+v"(wv[8]), "+v"(wv[9]), "+v"(wv[10]), "+v"(wv[11]), "+v"(wv[12]), "+v"(wv[13]), "+v"(wv[14]), "+v"(wv[15]));
#pragma unroll
          for (int k = 0; k < 16; ++k) { const float ov = OL[q * 128 + c0 + k]; a0 += ov * wv[k][0]; a1 += ov * wv[k][1]; } }
      *(unsigned*)(YS + (size_t)(NPR + 4 * n + t) * DM + 512 + h * VHD + d) = pk2(a0, a1); }
    __syncthreads();
}
#undef ATT_WAIT_BAR
}

template <class Fn> struct HookT { static constexpr bool ON = true; const Fn& f; __device__ __forceinline__ void operator()() const { f(); } };
constexpr int NPHASE = 22;
struct Args { InRaw in; float* out; unsigned char* ws; int ph_lo, ph_hi; };
__global__ void __launch_bounds__(NWAVES * 64, 2) fwd(Args args) {
    extern __shared__ __attribute__((aligned(16))) unsigned char lds[];
    Frame F;
    F.lds = (LAS unsigned char*)lds;
    F.MISC = (volatile LAS unsigned*)(F.lds + MISC_OFF);
    F.tid = threadIdx.x; F.lane = F.tid & 63; F.wave = __builtin_amdgcn_readfirstlane(F.tid >> 6);
    F.G = gridDim.x; { const int bx = blockIdx.x; F.vcu = (F.G % 8 == 0) ? (bx % 8) * (F.G / 8) + bx / 8 : bx; }
    F.ws = args.ws; F.out = args.out; F.ctl = (gu32*)(args.ws + WS_CTL);
    for (int u = F.tid; u < (LDS_BYTES - LDSCTL_OFF) / 4; u += NWAVES * 64) ((LAS unsigned*)(F.lds + LDSCTL_OFF))[u] = 0u;
    __syncthreads();
    InPtrs I; I.tab = (const LAS unsigned long long*)(F.lds + INTAB_OFF);
    if (F.tid < 33) ((LAS unsigned long long*)(F.lds + INTAB_OFF))[F.tid] = (unsigned long long)args.in.p[F.tid];
    __syncthreads();
#if MK_ONE_LAUNCH
    XcdBarrier bar = xcd_barrier_post((unsigned*)(F.ctl + CW_BAR), F.MISC + 8);
#define GRID_BAR() xcd_barrier(bar)
#else
#define GRID_BAR() do {} while (0)
#endif
    const int lo = args.ph_lo, hi = args.ph_hi;
#ifndef PHMASK
#define PHMASK 0xFFFu
#endif
#define EN(id) ((((PHMASK) >> (id)) & 1u) != 0u)
#define IN(k) (lo <= (k) && (k) < hi)
#define BOTH(k) (IN(k) && IN((k) + 1))
#ifndef REPMASK
#define REPMASK 0u
#endif
#define NREP(id) (1 + (int)(((REPMASK) >> (id)) & 1u))
#define LFRAME() Frame Fl = F; { int t_ = F.tid; asm volatile("" : "+v"(t_)); Fl.tid = t_; Fl.lane = t_ & 63; Fl.wave = __builtin_amdgcn_readfirstlane(t_ >> 6); int g_ = F.G, v_ = F.vcu, b_ = (int)blockIdx.x; asm volatile("" : "+s"(g_), "+s"(v_), "+s"(b_)); Fl.G = g_; Fl.vcu = v_; Fl.bid = b_; }
#define WSP (args.ws)
#define HB ((pg8::bf16_t*)(args.ws + WS_HB))
#define T ((pg8::bf16_t*)(args.ws + WS_T))
#define Z ((pg8::bf16_t*)(args.ws + WS_Z))
#define QL ((pg8::bf16_t*)(args.ws + WS_QL))
#define QB ((pg8::bf16_t*)(args.ws + WS_QB))
#define KB ((pg8::bf16_t*)(args.ws + WS_KB))
#define VB ((pg8::bf16_t*)(args.ws + WS_VB))
#define YS ((pg8::bf16_t*)(args.ws + WS_YS))
#define MG ((pg8::bf16_t*)(args.ws + WS_MG))
#define PART ((float*)(args.ws + WS_PART))
#define SSQ ((float*)(args.ws + WS_SSQ))

    if (EN(0) && IN(0)) { for (int rep = 0; rep < NREP(0); ++rep) { LFRAME(); p0_prologue(Fl, I, NREP(0) == 2 && rep == 0); if (rep + 1 < NREP(0)) GRID_BAR(); } if (BOTH(0)) GRID_BAR(); }

    for (int L = 0; L < 2; ++L) {
        const int pb = 1 + 10 * L;
#define wl (args.ws + WS_WL + (size_t)L * WL_STRIDE)
        if (EN(1) && IN(pb + 0)) { for (int rep = 0; rep < NREP(1); ++rep) { LFRAME(); pg8::Gemm g{DM, DM, DM}; pg8::OrderAB<1> S; S.init(MROWS, 2 * DFF, Fl.G, Fl.bid); S.A = (const char*)HB; S.B = (const char*)(wl + WL_GU1); S.a_tile = (size_t)256 * DM * 2; S.b_tile = (size_t)256 * DM * 2; S.a_sub = 0; S.b_sub = 0;
            pg8::EpiSwiGLU E{T, SSQ + (size_t)(3 * L) * SSQ_STRIDE, (NREP(1) == 2 && rep == 0 && ((REPMASK >> 16) & 1u)) ? 1 : 0, (LAS float*)(F.lds + QTILE_OFF)};
            pg8::gemm_phase<pg8::EpiSwiGLU, pg8::OrderAB<1>, true, true>(F.lds + RING_OFF, g, S, E);
            if (rep + 1 == NREP(1)) { if (L == 0) conv_drain_queue<1>(Fl, I, F.ctl + CW_CONVQ); else conv_drain_queue<4>(Fl, I, F.ctl + CW_CONVQ + 192); }
            if (rep + 1 < NREP(1)) GRID_BAR(); }
            if (BOTH(pb + 0)) GRID_BAR(); }
        if (EN(2) && IN(pb + 1)) { for (int rep = 0; rep < NREP(2); ++rep) { const bool dm = rep + 1 < NREP(2); LFRAME(); pg8::Gemm g{DFF, DFF, DFF}; pg8::OrderAB<1> S; S.init(NPR, DM, Fl.G, Fl.bid); S.A = (const char*)T; S.B = (const char*)(wl + WL_D1); S.a_tile = (size_t)256 * DFF * 2; S.b_tile = (size_t)256 * DFF * 2; S.a_sub = 0; S.b_sub = 0;
            pg8::EpiRes E{dm ? (pg8::bf16_t*)(WSP + WS_DUMH) : HB, dm ? (float*)(WSP + WS_DUMS) : SSQ + (size_t)(3 * L + 1) * SSQ_STRIDE, 0.5f};
            { MiniRes ME{dm ? (bf16*)(WSP + WS_DUMH) : (bf16*)HB, dm ? (float*)(WSP + WS_DUMS) : SSQ + (size_t)(3 * L + 1) * SSQ_STRIDE, 0.5f};
              auto hk = [&]() { mini_gemm<false>(F.lds + RING_OFF, (const bf16*)T + (size_t)NPR * DFF, DFF, (const bf16*)(wl + WL_D1), DFF, DFF, 0, 0, nullptr, ME, Fl.vcu, Fl.G); };
              pg8::gemm_phase<pg8::EpiRes, pg8::OrderAB<1>, true, true, HookT<decltype(hk)>>(F.lds + RING_OFF, g, S, E, HookT<decltype(hk)>{hk}); }
            if (dm) GRID_BAR(); }
            if (BOTH(pb + 1)) GRID_BAR(); }
        if (EN(3) && IN(pb + 2)) { for (int rep = 0; rep < NREP(3); ++rep) { LFRAME(); pg8::Gemm g{DM, DM, DM}; pg8::OrderAB<1> S; S.init(MROWS, INP, Fl.G, Fl.bid); S.A = (const char*)HB; S.B = (const char*)(wl + WL_IN); S.a_tile = (size_t)256 * DM * 2; S.b_tile = (size_t)256 * DM * 2; S.a_sub = 0; S.b_sub = 0;
            pg8::EpiZ E{Z, SSQ + (size_t)(3 * L + 1) * SSQ_STRIDE, (LAS float*)(F.lds + QTILE_OFF)};
            pg8::gemm_phase<pg8::EpiZ, pg8::OrderAB<1>, true, true>(F.lds + RING_OFF, g, S, E);
            if (rep + 1 == NREP(3)) { if (L == 0) conv_drain_queue<2>(Fl, I, F.ctl + CW_CONVQ + 64); else conv_drain_queue<5>(Fl, I, F.ctl + CW_CONVQ + 256); }
            if (rep + 1 < NREP(3)) GRID_BAR(); }
            if (BOTH(pb + 2)) GRID_BAR(); }
        if (EN(4) && IN(pb + 3)) { for (int rep = 0; rep < NREP(4); ++rep) { LFRAME(); p_prep(Fl, I, L); if (rep + 1 < NREP(4)) GRID_BAR(); } if (BOTH(pb + 3)) GRID_BAR(); }
        if (EN(5) && IN(pb + 4)) { for (int rep = 0; rep < NREP(5); ++rep) { LFRAME(); pg8::Gemm g{384, 384, 384}; pg8::OrderAB<1> S; S.init(NPR, 1024, Fl.G, Fl.bid); S.A = (const char*)QL; S.B = (const char*)(WSP + WS_WCAT + (size_t)L * WCAT_BYTES); S.a_tile = (size_t)256 * 384 * 2; S.b_tile = (size_t)256 * 384 * 2; S.a_sub = 0; S.b_sub = 0;
            pg8::EpiMla E{QB, KB, VB, (const float*)(WSP + WS_ROPE)};
            { MiniMla ME{(bf16*)QB, (bf16*)KB, (bf16*)VB, (const float*)(WSP + WS_ROPE)};
              auto hk = [&]() { mini_gemm<false>(F.lds + RING_OFF, (const bf16*)QL + (size_t)NPR * 384, 384, (const bf16*)(WSP + WS_WCAT + (size_t)L * WCAT_BYTES), 384, 384, 0, 0, nullptr, ME, Fl.vcu, Fl.G); };
              pg8::gemm_phase<pg8::EpiMla, pg8::OrderAB<1>, true, true, HookT<decltype(hk)>>(F.lds + RING_OFF, g, S, E, HookT<decltype(hk)>{hk}); }
            if (rep + 1 < NREP(5)) GRID_BAR(); }
            if (BOTH(pb + 4)) GRID_BAR(); }
        if (EN(6) && IN(pb + 5)) { for (int rep = 0; rep < NREP(6); ++rep) { LFRAME();
            if (!(rep == 1 && ((REPMASK >> 13) & 1u))) if ((Fl.vcu & 1) == 0) for (int n = Fl.vcu >> 1; n < NSEQ_S; n += (Fl.G + 1) >> 1) att::decode_seq(n, L, I, (const bf16*)QB, F.out, (bf16*)YS, F.lds + RING_OFF);
            const int home = (int)(xb_xcc_id() & 7u);
            for (int kq = 0; kq < 8; ++kq) { const int bh = (home + kq) & 7;
                gu32* qh = F.ctl + CW_Q + ((L * 2 + rep) * 8 + bh) * 64;
                for (;;) {
                    __syncthreads();
                    if (Fl.tid == 0) F.MISC[0] = __hip_atomic_fetch_add(qh, 1u, RLX_AGENT);
                    __syncthreads();
                    const int item = (int)F.MISC[0];
                    if (item >= 64 || (rep == 1 && ((REPMASK >> 12) & 1u))) break;
                    att::flash_unit(bh >> 2, bh & 3, 63 - item, (const bf16*)QB, (const bf16*)KB, (const bf16*)VB, (bf16*)YS, F.lds + RING_OFF);
                } }
            if (rep + 1 < NREP(6)) GRID_BAR(); }
            if (BOTH(pb + 5)) GRID_BAR(); }
        if (EN(7) && IN(pb + 6)) { for (int rep = 0; rep < NREP(7); ++rep) { LFRAME(); pg8::Gemm g{DM, BRW, BRW}; pg8::OrderAB<4> S; S.init(NPR, DM, Fl.G, Fl.bid); S.A = (const char*)YS; S.B = (const char*)(wl + WL_BR); S.a_tile = (size_t)256 * DM * 2; S.b_tile = (size_t)256 * BRW * 2; S.a_sub = (size_t)BRW * 2; S.b_sub = (size_t)DM * BRW * 2;
            pg8::EpiBranch E{Z, MG};
            { MiniBranch ME{(bf16*)MG};
              auto hk = [&]() { mini_gemm<true>(F.lds + RING_OFF, (const bf16*)YS + (size_t)NPR * DM, DM, (const bf16*)(wl + WL_BR), BRW, BRW, (size_t)BRW, (size_t)DM * BRW, (const bf16*)Z, ME, Fl.vcu, Fl.G); };
              pg8::gemm_phase<pg8::EpiBranch, pg8::OrderAB<4>, true, true, HookT<decltype(hk)>>(F.lds + RING_OFF, g, S, E, HookT<decltype(hk)>{hk}); }
            if (rep + 1 < NREP(7)) GRID_BAR(); }
            if (BOTH(pb + 6)) GRID_BAR(); }
        if (EN(8) && IN(pb + 7)) { for (int rep = 0; rep < NREP(8); ++rep) { const bool dm = rep + 1 < NREP(8); LFRAME(); pg8::Gemm g{DM, DM, DM}; pg8::OrderAB<1> S; S.init(NPR, DM, Fl.G, Fl.bid); S.A = (const char*)MG; S.B = (const char*)(wl + WL_O); S.a_tile = (size_t)256 * DM * 2; S.b_tile = (size_t)256 * DM * 2; S.a_sub = 0; S.b_sub = 0;
            pg8::EpiRes E{dm ? (pg8::bf16_t*)(WSP + WS_DUMH) : HB, dm ? (float*)(WSP + WS_DUMS) : SSQ + (size_t)(3 * L + 2) * SSQ_STRIDE, 1.0f};
            { MiniRes ME{dm ? (bf16*)(WSP + WS_DUMH) : (bf16*)HB, dm ? (float*)(WSP + WS_DUMS) : SSQ + (size_t)(3 * L + 2) * SSQ_STRIDE, 1.0f};
              auto hk = [&]() { mini_gemm<false>(F.lds + RING_OFF, (const bf16*)MG + (size_t)NPR * DM, DM, (const bf16*)(wl + WL_O), DM, DM, 0, 0, nullptr, ME, Fl.vcu, Fl.G); };
              pg8::gemm_phase<pg8::EpiRes, pg8::OrderAB<1>, true, true, HookT<decltype(hk)>>(F.lds + RING_OFF, g, S, E, HookT<decltype(hk)>{hk}); }
            if (dm) GRID_BAR(); }
            if (BOTH(pb + 7)) GRID_BAR(); }
        if (EN(9) && IN(pb + 8)) { for (int rep = 0; rep < NREP(9); ++rep) { LFRAME(); pg8::Gemm g{DM, DM, DM}; pg8::OrderAB<1> S; S.init(MROWS, 2 * DFF, Fl.G, Fl.bid); S.A = (const char*)HB; S.B = (const char*)(wl + WL_GU2); S.a_tile = (size_t)256 * DM * 2; S.b_tile = (size_t)256 * DM * 2; S.a_sub = 0; S.b_sub = 0;
            pg8::EpiSwiGLU E{T, SSQ + (size_t)(3 * L + 2) * SSQ_STRIDE, 0, (LAS float*)(F.lds + QTILE_OFF)};
            pg8::gemm_phase<pg8::EpiSwiGLU, pg8::OrderAB<1>, true, true>(F.lds + RING_OFF, g, S, E);
            if (L == 0 && rep + 1 == NREP(9)) conv_drain_queue<3>(Fl, I, F.ctl + CW_CONVQ + 128);
            if (rep + 1 < NREP(9)) GRID_BAR(); }
            if (BOTH(pb + 8)) GRID_BAR(); }
        if (EN(10) && IN(pb + 9)) { for (int rep = 0; rep < NREP(10); ++rep) { const bool dm = rep + 1 < NREP(10); LFRAME(); pg8::Gemm g{DFF, DFF, DFF}; pg8::OrderAB<1> S; S.init(NPR, DM, Fl.G, Fl.bid); S.A = (const char*)T; S.B = (const char*)(wl + WL_D2); S.a_tile = (size_t)256 * DFF * 2; S.b_tile = (size_t)256 * DFF * 2; S.a_sub = 0; S.b_sub = 0;
            pg8::EpiRes E{dm ? (pg8::bf16_t*)(WSP + WS_DUMH) : HB, dm ? (float*)(WSP + WS_DUMS) : SSQ + (size_t)(3 * L + 3) * SSQ_STRIDE, 0.5f};
            { MiniRes ME{dm ? (bf16*)(WSP + WS_DUMH) : (bf16*)HB, dm ? (float*)(WSP + WS_DUMS) : SSQ + (size_t)(3 * L + 3) * SSQ_STRIDE, 0.5f};
              auto hk = [&]() { mini_gemm<false>(F.lds + RING_OFF, (const bf16*)T + (size_t)NPR * DFF, DFF, (const bf16*)(wl + WL_D2), DFF, DFF, 0, 0, nullptr, ME, Fl.vcu, Fl.G); };
              pg8::gemm_phase<pg8::EpiRes, pg8::OrderAB<1>, true, true, HookT<decltype(hk)>>(F.lds + RING_OFF, g, S, E, HookT<decltype(hk)>{hk}); }
            if (dm) GRID_BAR(); }
            if (BOTH(pb + 9)) GRID_BAR(); }
    }
    if (EN(11) && IN(21)) { LFRAME(); p_final(Fl, I); }
#undef IN
#undef BOTH
#undef WSP
#undef HB
#undef T
#undef Z
#undef QL
#undef QB
#undef KB
#undef VB
#undef YS
#undef MG
#undef PART
#undef SSQ
#undef wl
}

extern "C" void kernel_launch(void* const* d_in, const int* in_sizes, int n_in, void* d_out, int out_size, void* d_ws, size_t ws_size, hipStream_t stream) {
    static int grid = 0;
    if (grid == 0) {
        if (n_in != 33 || (size_t)out_size != OUT_TOTAL || ws_size < WS_END) { fprintf(stderr, "kernel_launch: unexpected problem shape (n_in %d, out %d, ws %zu); nothing launched\n", n_in, out_size, ws_size); grid = -1; return; }
        int dev = 0, cus = 0, per_cu = 0;
        if (hipGetDevice(&dev) != hipSuccess || hipDeviceGetAttribute(&cus, hipDeviceAttributeMultiprocessorCount, dev) != hipSuccess) { grid = -1; return; }
        if (hipFuncSetAttribute((const void*)fwd, hipFuncAttributeMaxDynamicSharedMemorySize, LDS_BYTES) != hipSuccess) { fprintf(stderr, "kernel_launch: hipFuncSetAttribute failed\n"); grid = -1; return; }
        if (hipOccupancyMaxActiveBlocksPerMultiprocessor(&per_cu, (const void*)fwd, NWAVES * 64, LDS_BYTES) != hipSuccess || per_cu < 1) { fprintf(stderr, "kernel_launch: occupancy query reports %d workgroups per CU\n", per_cu); }
        (void)hipGetLastError();
        grid = cus;
    }
    if (grid < 0) return;
    if (hipMemsetAsync((char*)d_ws + WS_CTL, 0, CTL_ZERO_BYTES, stream) != hipSuccess) { fprintf(stderr, "kernel_launch: hipMemsetAsync failed\n"); return; }
    Args a{};
    for (int i = 0; i < 33; ++i) a.in.p[i] = (const float*)d_in[i];
    a.out = (float*)d_out; a.ws = (unsigned char*)d_ws;
#if MK_ONE_LAUNCH
    a.ph_lo = 0; a.ph_hi = NPHASE;
    hipLaunchKernelGGL(fwd, dim3(grid), dim3(NWAVES * 64), LDS_BYTES, stream, a);
#else
    for (int ph = 0; ph < NPHASE; ++ph) { a.ph_lo = ph; a.ph_hi = ph + 1; hipLaunchKernelGGL(fwd, dim3(grid), dim3(NWAVES * 64), LDS_BYTES, stream, a); }
#endif
    const hipError_t le = hipPeekAtLastError();
    if (le != hipSuccess) fprintf(stderr, "kernel_launch: launch failed: %s\n", hipGetErrorName(le));
}
```
